# Optimizing an MI355X kernel written in HIP

```python
import math
import jax, jax.numpy as jnp
from jax import lax
import numpy as np

D_MODEL = 1024
BATCH = 8
SEQ = 2048
DEPTH = 1
DEC_BATCH = 128
DEC_SEQ = 1
PAST_LEN = 16384
PAGE_SIZE = 128

MIX_WIDTH = D_MODEL
MLSTM_WIDTH = MIX_WIDTH // 2
POOL_WIDTH = MIX_WIDTH - MLSTM_WIDTH
N_HEADS = 4
HEAD_DIM = MLSTM_WIDTH // N_HEADS
POOL_WINDOWS = (2, 4, 8, 16)
N_POOL_GROUPS = len(POOL_WINDOWS)
POOL_GROUP_DIM = POOL_WIDTH // N_POOL_GROUPS
POOL_BUF = max(POOL_WINDOWS) - 1
D_FF = 4 * D_MODEL
CHUNK = 64
EPS = 1e-6
IN_COLS = 4 * MLSTM_WIDTH + 2 * N_HEADS + POOL_WIDTH

kernel_name = "hymba_mlstm_pool_adaln_step"


def _rmsnorm(x, g):
    xf = x.astype(jnp.float32)
    y = xf * lax.rsqrt(jnp.mean(xf * xf, axis=-1, keepdims=True) + EPS)
    return y * g.astype(jnp.float32)


def _mlstm_chunk(carry, xs):
    C0, n0, m0 = carry
    q, k, v, logf, ig = xs
    L = q.shape[2]
    b = jnp.cumsum(logf, axis=-1)
    causal = jnp.tril(jnp.ones((L, L), dtype=bool))
    dmat = b[..., :, None] - b[..., None, :] + ig[..., None, :]
    dmat = jnp.where(causal, dmat, -jnp.inf)
    g = b + m0[..., None]
    m = jnp.maximum(g, jnp.max(dmat, axis=-1))
    w = jnp.exp(dmat - m[..., None])
    a = jnp.exp(g - m)
    s = jnp.einsum('bhtd,bhsd->bhts', q, k) * w
    num = a[..., None] * jnp.einsum('bhtd,bhde->bhte', q, C0) + jnp.einsum('bhts,bhse->bhte', s, v)
    den = a * jnp.einsum('bhtd,bhd->bht', q, n0) + jnp.sum(s, axis=-1)
    h = num / jnp.maximum(jnp.abs(den), jnp.exp(-m))[..., None]
    mL = m[..., -1]
    aL = jnp.exp(g[..., -1] - mL)
    wL = jnp.exp(b[..., -1:] - b + ig - mL[..., None])
    C1 = aL[..., None, None] * C0 + jnp.einsum('bhs,bhsd,bhse->bhde', wL, k, v)
    n1 = aL[..., None] * n0 + jnp.einsum('bhs,bhsd->bhd', wL, k)
    return (C1, n1, mL), h


def _mlstm_sequence(q, k, v, logf, ig, C0, n0, m0):
    B, H, L, Dh = q.shape
    lc = CHUNK if L % CHUNK == 0 else L
    nc = L // lc

    def to_chunks(t):
        t = t.reshape(t.shape[:2] + (nc, lc) + t.shape[3:])
        return jnp.moveaxis(t, 2, 0)

    xs = (to_chunks(q), to_chunks(k), to_chunks(v), to_chunks(logf), to_chunks(ig))
    (C1, n1, m1), h = lax.scan(_mlstm_chunk, (C0, n0, m0), xs)
    h = jnp.moveaxis(h, 0, 2).reshape(B, H, L, Dh)
    return h, C1, n1, m1


def _pool_mixer(u, buf, pos0, w_pool, pool_scale):
    B, L, P = u.shape
    ext = jnp.concatenate([buf.astype(jnp.float32), u], axis=1)
    cs = jnp.cumsum(ext, axis=1)
    cs = jnp.pad(cs, ((0, 0), (1, 0), (0, 0)))
    pos = (pos0 + jnp.arange(L)).astype(jnp.float32)
    means = []
    for gi, win in enumerate(POOL_WINDOWS):
        sl = slice(gi * POOL_GROUP_DIM, (gi + 1) * POOL_GROUP_DIM)
        end = cs[:, POOL_BUF + 1:, sl]
        start = cs[:, POOL_BUF + 1 - win:POOL_BUF + 1 - win + L, sl]
        cnt = jnp.minimum(pos + 1.0, float(win))[None, :, None]
        means.append((end - start) / cnt)
    pooled = jnp.concatenate(means, axis=-1) - u
    pooled = pooled.reshape(B, L, N_POOL_GROUPS, POOL_GROUP_DIM)
    out = jnp.einsum('blgc,gcd->blgd', pooled, w_pool.astype(jnp.float32)).reshape(B, L, P)
    return out * pool_scale.astype(jnp.float32), ext[:, -POOL_BUF:]


def _layer(x, c, C0, n0, m0, buf, pos0, w_ada, b_ada, g_pre1, g_post1, w_in, b_ig, b_fg,
           g_head, w_pool, pool_scale, w_out, g_pre2, g_post2, w_up, w_down):
    dt = x.dtype
    B, L, _ = x.shape
    f32 = jnp.float32
    mod = jnp.einsum('bd,de->be', jax.nn.silu(c.astype(f32)), w_ada.astype(f32)) + b_ada.astype(f32)
    sh1, sc1, ga1, sh2, sc2, ga2 = jnp.split(mod[:, None, :], 6, axis=-1)

    hn = (_rmsnorm(x, g_pre1) * (1.0 + sc1) + sh1).astype(dt)
    z = jnp.einsum('bld,de->ble', hn, w_in).astype(f32)
    Wm = MLSTM_WIDTH
    q, k, v, o = z[..., :Wm], z[..., Wm:2 * Wm], z[..., 2 * Wm:3 * Wm], z[..., 3 * Wm:4 * Wm]
    ig = z[..., 4 * Wm:4 * Wm + N_HEADS] + b_ig.astype(f32)
    fg = z[..., 4 * Wm + N_HEADS:4 * Wm + 2 * N_HEADS] + b_fg.astype(f32)
    u = z[..., 4 * Wm + 2 * N_HEADS:]

    def heads(t):
        return t.reshape(B, L, N_HEADS, HEAD_DIM).transpose(0, 2, 1, 3)

    qh, kh, vh = heads(q), heads(k) * (HEAD_DIM ** -0.5), heads(v)
    logf = jax.nn.log_sigmoid(fg).transpose(0, 2, 1)
    igh = ig.transpose(0, 2, 1)
    h, C1, n1, m1 = _mlstm_sequence(qh, kh, vh, logf, igh, C0.astype(f32), n0.astype(f32), m0.astype(f32))
    h = h.transpose(0, 2, 1, 3)
    h = _rmsnorm(h, g_head) * jax.nn.sigmoid(heads(o).transpose(0, 2, 1, 3))
    h = h.reshape(B, L, Wm)

    p_out, buf1 = _pool_mixer(u, buf, pos0, w_pool, pool_scale)
    mix = jnp.concatenate([h, p_out], axis=-1).astype(dt)
    mix = jnp.einsum('blm,md->bld', mix, w_out)
    x = (x.astype(f32) + ga1 * _rmsnorm(mix, g_post1)).astype(dt)

    hn2 = (_rmsnorm(x, g_pre2) * (1.0 + sc2) + sh2).astype(dt)
    f = jnp.square(jax.nn.relu(jnp.einsum('bld,df->blf', hn2, w_up)))
    f = jnp.einsum('blf,fd->bld', f, w_down)
    x = (x.astype(f32) + ga2 * _rmsnorm(f, g_post2)).astype(dt)
    return x, C1, n1, m1, buf1


def setup_inputs(seed: int = 0) -> dict:
    key = jax.random.key(seed)
    ks = jax.random.split(key, 24)
    nrm = jax.random.normal
    f32 = jnp.float32
    d = {}
    d['x_prompt'] = nrm(ks[0], (BATCH, SEQ, D_MODEL), f32)
    d['x_sample'] = nrm(ks[1], (DEC_BATCH, DEC_SEQ, D_MODEL), f32)
    d['c_prompt'] = nrm(ks[2], (BATCH, D_MODEL), f32)
    d['c_sample'] = nrm(ks[3], (DEC_BATCH, D_MODEL), f32)
    d['state_C'] = nrm(ks[4], (DEPTH, DEC_BATCH, N_HEADS, HEAD_DIM, HEAD_DIM), f32) * HEAD_DIM ** -0.5
    d['state_n'] = nrm(ks[5], (DEPTH, DEC_BATCH, N_HEADS, HEAD_DIM), f32) * 0.5
    d['state_m'] = nrm(ks[6], (DEPTH, DEC_BATCH, N_HEADS), f32)
    d['state_pool'] = nrm(ks[7], (DEPTH, DEC_BATCH, POOL_BUF, POOL_WIDTH), f32)
    d['w_ada'] = nrm(ks[8], (DEPTH, D_MODEL, 6 * D_MODEL), f32) * D_MODEL ** -0.5
    d['b_ada'] = nrm(ks[9], (DEPTH, 6 * D_MODEL), f32) * 0.02
    d['g_pre1'] = 1.0 + 0.05 * nrm(ks[10], (DEPTH, D_MODEL), f32)
    d['g_post1'] = 1.0 + 0.05 * nrm(ks[11], (DEPTH, D_MODEL), f32)
    d['w_in'] = nrm(ks[12], (DEPTH, D_MODEL, IN_COLS), f32) * D_MODEL ** -0.5
    d['b_ig'] = 0.1 * nrm(ks[13], (DEPTH, N_HEADS), f32)
    d['b_fg'] = jnp.linspace(3.0, 6.0, N_HEADS, dtype=f32)[None, :] + 0.1 * nrm(ks[14], (DEPTH, N_HEADS), f32)
    d['g_head'] = 1.0 + 0.05 * nrm(ks[15], (DEPTH, HEAD_DIM), f32)
    d['w_pool'] = nrm(ks[16], (DEPTH, N_POOL_GROUPS, POOL_GROUP_DIM, POOL_GROUP_DIM), f32) * POOL_GROUP_DIM ** -0.5
    d['pool_scale'] = 0.5 + 0.1 * nrm(ks[17], (DEPTH, POOL_WIDTH), f32)
    d['w_out'] = nrm(ks[18], (DEPTH, MIX_WIDTH, D_MODEL), f32) * MIX_WIDTH ** -0.5
    d['g_pre2'] = 1.0 + 0.05 * nrm(ks[19], (DEPTH, D_MODEL), f32)
    d['g_post2'] = 1.0 + 0.05 * nrm(ks[20], (DEPTH, D_MODEL), f32)
    d['w_up'] = nrm(ks[21], (DEPTH, D_MODEL, D_FF), f32) * D_MODEL ** -0.5
    d['w_down'] = nrm(ks[22], (DEPTH, D_FF, D_MODEL), f32) * D_FF ** -0.5
    return d


def reference(x_prompt, x_sample, c_prompt, c_sample, state_C, state_n, state_m, state_pool,
              w_ada, b_ada, g_pre1, g_post1, w_in, b_ig, b_fg, g_head, w_pool, pool_scale,
              w_out, g_pre2, g_post2, w_up, w_down):
    f32 = jnp.float32
    xp, xs = x_prompt, x_sample
    Cp_l, np_l, mp_l, pp_l = [], [], [], []
    Cs_l, ns_l, ms_l, ps_l = [], [], [], []
    for l in range(DEPTH):
        w = (w_ada[l], b_ada[l], g_pre1[l], g_post1[l], w_in[l], b_ig[l], b_fg[l], g_head[l],
             w_pool[l], pool_scale[l], w_out[l], g_pre2[l], g_post2[l], w_up[l], w_down[l])
        C0 = jnp.zeros((BATCH, N_HEADS, HEAD_DIM, HEAD_DIM), f32)
        n0 = jnp.zeros((BATCH, N_HEADS, HEAD_DIM), f32)
        m0 = jnp.zeros((BATCH, N_HEADS), f32)
        b0 = jnp.zeros((BATCH, POOL_BUF, POOL_WIDTH), f32)
        xp, Cp, npv, mp, pp = _layer(xp, c_prompt, C0, n0, m0, b0, 0, *w)
        xs, Cs, nsv, ms, ps = _layer(xs, c_sample, state_C[l], state_n[l], state_m[l], state_pool[l], PAST_LEN, *w)
        Cp_l.append(Cp.astype(x_prompt.dtype)); np_l.append(npv.astype(x_prompt.dtype))
        mp_l.append(mp.astype(x_prompt.dtype)); pp_l.append(pp.astype(x_prompt.dtype))
        Cs_l.append(Cs.astype(state_C.dtype)); ns_l.append(nsv.astype(state_n.dtype))
        ms_l.append(ms.astype(state_m.dtype)); ps_l.append(ps.astype(state_pool.dtype))
    return (xp, xs,
            jnp.stack(Cp_l), jnp.stack(np_l), jnp.stack(mp_l), jnp.stack(pp_l),
            jnp.stack(Cs_l), jnp.stack(ns_l), jnp.stack(ms_l), jnp.stack(ps_l))
```

```cpp
#include <hip/hip_runtime.h>
#include <hip/hip_cooperative_groups.h>
#include <cstdio>
#include <cstdint>
namespace cg = cooperative_groups;
namespace pg8 {
#define PG8_LAS __attribute__((address_space(3)))
typedef unsigned short bf16_t;
typedef short bf16x8 __attribute__((ext_vector_type(8)));
typedef float f32x4 __attribute__((ext_vector_type(4)));
typedef unsigned u32x4 __attribute__((ext_vector_type(4)));
constexpr int BM = 256, BK = 64, HALF = 128, HTB = HALF * BK * 2  , STAGE_BYTES = 8 * HTB, NXCD = 8, WGM = 8;

__host__ __device__ __forceinline__ int lds_byte(int r, int c) { const int st = (r >> 4) * 2 + (c >> 5), rr = r & 15, cc = c & 31, ob = rr * 64 + cc * 2; return st * 1024 + (ob ^ (((ob >> 9) & 1) << 5)); }
__host__ __device__ __forceinline__ void stage_rc(int b, int& R, int& C) { const int st = b / 1024, sb = b % 1024, swz = sb ^ (((sb >> 9) & 1) << 5); R = (st >> 1) * 16 + swz / 64; C = (st & 1) * 32 + (swz % 64) / 2; }
__host__ __device__ __forceinline__ int perm32(int rho) { const int n = rho >> 4, i = rho & 15; return 8 * (i >> 2) + 4 * n + (i & 3); }

struct Unit { int pm, pn; };
struct Gemm { const bf16_t* A; const bf16_t* Bt; int M, N, K; };

struct StaticOrder {
    int nM, nN, nwg, G, c;
    __host__ __device__ void init(int M, int N, int G_, int c_) { nM = M / BM; nN = N / BM; nwg = nM * nN; G = G_; c = c_; }
    __host__ __device__ bool next(int i, Unit& u) const {
        const long L = (long)i * G + c; if (L >= nwg) return false;
        int wgid = (int)L; { const int q = nwg / NXCD, r = nwg % NXCD, xcd = wgid % NXCD, off = wgid / NXCD; wgid = (xcd < r ? xcd * (q + 1) : r * (q + 1) + (xcd - r) * q) + off; }
        const int nig = WGM * nN, gid = wgid / nig, fm = gid * WGM, gsz = (nM - fm) < WGM ? (nM - fm) : WGM;
        u.pm = fm + ((wgid % nig) % gsz); u.pn = (wgid % nig) / gsz; return true;
    }
    __device__ __forceinline__ void a_ready(const Unit&) const {}
    __device__ __forceinline__ void done(const Unit&) const {}
};

__device__ __forceinline__ unsigned cvt_pk_bf16(float lo, float hi) { unsigned r; asm volatile("v_cvt_pk_bf16_f32 %0, %1, %2" : "=v"(r) : "v"(lo), "v"(hi)); return r; }
template <int ACT  > struct EpiB16 {
    static constexpr bool PERM = true, AFTER_DRAIN = false;
    bf16_t* O; int ldc;
    __device__ __forceinline__ void operator()(const f32x4 (&acc)[2][2][4][2], const Unit& u, int wr, int wc, int fr, int fq) const {
        const int row0 = u.pm * BM + wr * 64 + fr; const int col0 = u.pn * BM + wc * 32 + 8 * fq;
#pragma unroll
        for (int ai = 0; ai < 2; ++ai)
#pragma unroll
            for (int m = 0; m < 4; ++m) { bf16_t* rowp = O + (size_t)(row0 + ai * HALF + m * 16) * ldc + col0;
#pragma unroll
                for (int bj = 0; bj < 2; ++bj) { f32x4 v0 = acc[ai][bj][m][0], v1 = acc[ai][bj][m][1];
                    if (ACT == 1) {
#pragma unroll
                        for (int i = 0; i < 4; ++i) { float a = fmaxf(v0[i], 0.f), b = fmaxf(v1[i], 0.f); v0[i] = a * a; v1[i] = b * b; } }
                    u32x4 w; w.x = cvt_pk_bf16(v0[0], v0[1]); w.y = cvt_pk_bf16(v0[2], v0[3]); w.z = cvt_pk_bf16(v1[0], v1[1]); w.w = cvt_pk_bf16(v1[2], v1[3]);
                    *(u32x4*)(rowp + bj * HALF) = w; } }
    }
};
struct EpiF32 {
    static constexpr bool PERM = false, AFTER_DRAIN = false;
    float* O; int ldc;
    __device__ __forceinline__ void operator()(const f32x4 (&acc)[2][2][4][2], const Unit& u, int wr, int wc, int fr, int fq) const {
#pragma unroll
        for (int ai = 0; ai < 2; ++ai)
#pragma unroll
            for (int m = 0; m < 4; ++m) { float* rowp = O + (size_t)(u.pm * BM + ai * HALF + wr * 64 + m * 16 + fr) * ldc + u.pn * BM + wc * 32 + 4 * fq;
#pragma unroll
                for (int bj = 0; bj < 2; ++bj)
#pragma unroll
                    for (int n = 0; n < 2; ++n) *(f32x4*)(rowp + bj * HALF + n * 16) = acc[ai][bj][m][n]; }
    }
};
template <class Epi, class Sched, bool ALIGN_EPI = false, bool SP2 = false>
__device__ __forceinline__ void gemm_phase(PG8_LAS unsigned char* lds, const Gemm g, const Sched& S, const Epi& E) {
    const int tid = threadIdx.x, wid = __builtin_amdgcn_readfirstlane(tid >> 6), lane = tid & 63, wr = wid >> 2, wc = wid & 3, fr = lane & 15, fq = lane >> 4;
    const int K = g.K, nt = K / BK;
    unsigned voffA[2], voffB[2];
#pragma unroll
    for (int i = 0; i < 2; ++i) { int R, C; stage_rc(tid * 16 + i * 8192, R, C); const int Rb = Epi::PERM ? ((R & ~31) + perm32(R & 31)) : R;
        voffA[i] = (unsigned)(R * K + C) * 2u; voffB[i] = (unsigned)(Rb * K + C) * 2u; }
    const size_t kstep = (size_t)(BK * 2);
    const size_t hstep = (size_t)HALF * K * 2;
    const size_t tstep = 2 * hstep;
    const unsigned ldsw = (unsigned)wid * 1024u;
    const int aoff = lds_byte(wr * 64 + fr, fq * 8), boff = lds_byte(wc * 32 + fr, fq * 8);
#define PG8_SA(b, h) (((b) * 2 + (h)) * HTB)
#define PG8_SB(b, h) ((4 + (b) * 2 + (h)) * HTB)
#define PG8_STAGE(bufoff, gbase, voff) do { _Pragma("unroll") for (int _i = 0; _i < 2; ++_i) \
        __builtin_amdgcn_global_load_lds((const unsigned*)((const char*)(gbase) + (voff)[_i]), (PG8_LAS unsigned*)(lds + (bufoff) + ldsw + _i * 8192), 16, 0, 0); } while (0)
#define PG8_LDA(dst, b, h) do { _Pragma("unroll") for (int m = 0; m < 4; ++m) _Pragma("unroll") for (int k = 0; k < 2; ++k) dst[m][k] = *(const PG8_LAS bf16x8*)(lds + PG8_SA(b, h) + aoff + m * 2048 + k * 1024); } while (0)
#define PG8_LDB(dst, b, h) do { _Pragma("unroll") for (int n = 0; n < 2; ++n) _Pragma("unroll") for (int k = 0; k < 2; ++k) dst[n][k] = *(const PG8_LAS bf16x8*)(lds + PG8_SB(b, h) + boff + n * 2048 + k * 1024); } while (0)
#define PG8_MMA(ai, bj, At, Bt) do { __builtin_amdgcn_s_setprio(1); _Pragma("unroll") for (int m = 0; m < 4; ++m) _Pragma("unroll") for (int n = 0; n < 2; ++n) _Pragma("unroll") for (int k = 0; k < 2; ++k) \
        acc[ai][bj][m][n] = __builtin_amdgcn_mfma_f32_16x16x32_bf16(Bt[n][k], At[m][k], acc[ai][bj][m][n], 0, 0, 0); __builtin_amdgcn_s_setprio(0); } while (0)
#define PG8_WAIT_V(n) asm volatile("s_waitcnt vmcnt(" #n ")" ::: "memory")
#define PG8_WAIT_L(n) asm volatile("s_waitcnt lgkmcnt(" #n ")" ::: "memory")
#define PG8_BAR __builtin_amdgcn_s_barrier()
#define PG8_SCHED __builtin_amdgcn_sched_barrier(0)
    Unit cur, nxt; int ui = 0;
    if (!S.next(0, cur)) return;
    f32x4 acc[2][2][4][2];
#pragma unroll
    for (int a = 0; a < 2; ++a)
#pragma unroll
        for (int b = 0; b < 2; ++b)
#pragma unroll
            for (int m = 0; m < 4; ++m)
#pragma unroll
                for (int n = 0; n < 2; ++n) acc[a][b][m][n] = (f32x4){0.f, 0.f, 0.f, 0.f};
    bf16x8 At[4][2], B0[2][2], B1[2][2];
    const char* cA = (const char*)g.A + (size_t)cur.pm * tstep; const char* cB = (const char*)g.Bt + (size_t)cur.pn * tstep;
    S.a_ready(cur);
    if constexpr (SP2) {
        PG8_STAGE(PG8_SB(0, 0), cB, voffB); PG8_STAGE(PG8_SB(0, 1), cB + hstep, voffB); PG8_STAGE(PG8_SA(0, 0), cA, voffA); PG8_STAGE(PG8_SA(0, 1), cA + hstep, voffA);
        if (wr == 1) PG8_BAR;
        PG8_WAIT_V(2); PG8_BAR;
        PG8_STAGE(PG8_SB(1, 0), cB + kstep, voffB); PG8_STAGE(PG8_SA(1, 0), cA + kstep, voffA); PG8_STAGE(PG8_SB(1, 1), cB + hstep + kstep, voffB);
        PG8_WAIT_V(6); PG8_BAR;
    } else {
        PG8_STAGE(PG8_SB(0, 0), cB, voffB); PG8_STAGE(PG8_SA(0, 0), cA, voffA); PG8_STAGE(PG8_SB(0, 1), cB + hstep, voffB); PG8_STAGE(PG8_SA(0, 1), cA + hstep, voffA);
        if (wr == 1) PG8_BAR;
        PG8_WAIT_V(4); PG8_BAR;
        PG8_STAGE(PG8_SB(1, 0), cB + kstep, voffB); PG8_STAGE(PG8_SA(1, 0), cA + kstep, voffA); PG8_STAGE(PG8_SB(1, 1), cB + hstep + kstep, voffB);
        PG8_WAIT_V(6); PG8_BAR;
    }
    for (;;) {
        const bool has_next = S.next(ui + 1, nxt);
        const char* nA = has_next ? (const char*)g.A + (size_t)nxt.pm * tstep : cA; const char* nB = has_next ? (const char*)g.Bt + (size_t)nxt.pn * tstep : cB;
        for (int t = 0; t < nt; t += 2) {
            const bool last = (t == nt - 2);
            const char* a1 = cA + (size_t)(t + 1) * kstep;
            const char* a2 = last ? nA : cA + (size_t)(t + 2) * kstep; const char* b2 = last ? nB : cB + (size_t)(t + 2) * kstep;
            const char* a3 = a2 + kstep; const char* b3 = b2 + kstep;
            if (last && has_next) S.a_ready(nxt);
            if constexpr (SP2) {
            PG8_LDB(B0, 0, 0); PG8_LDB(B1, 0, 1); PG8_SCHED; PG8_LDA(At, 0, 0); PG8_STAGE(PG8_SA(1, 1), a1 + hstep, voffA);
            PG8_WAIT_V(8); PG8_WAIT_L(0); PG8_BAR; PG8_MMA(0, 0, At, B0); PG8_MMA(0, 1, At, B1); PG8_BAR; PG8_SCHED;
            PG8_LDA(At, 0, 1); PG8_STAGE(PG8_SB(0, 0), b2, voffB); PG8_STAGE(PG8_SB(0, 1), b2 + hstep, voffB); PG8_STAGE(PG8_SA(0, 0), a2, voffA);
            PG8_WAIT_V(8); PG8_WAIT_L(0); PG8_BAR; PG8_MMA(1, 0, At, B0); PG8_MMA(1, 1, At, B1); PG8_BAR; PG8_SCHED;
            PG8_LDB(B0, 1, 0); PG8_LDB(B1, 1, 1); PG8_SCHED; PG8_LDA(At, 1, 0); PG8_STAGE(PG8_SA(0, 1), a2 + hstep, voffA);
            PG8_WAIT_V(8); PG8_WAIT_L(0); PG8_BAR; PG8_MMA(0, 0, At, B0); PG8_MMA(0, 1, At, B1); PG8_BAR; PG8_SCHED;
            PG8_LDA(At, 1, 1); PG8_STAGE(PG8_SB(1, 0), b3, voffB); PG8_STAGE(PG8_SB(1, 1), b3 + hstep, voffB); PG8_STAGE(PG8_SA(1, 0), a3, voffA);
            PG8_WAIT_V(8); PG8_WAIT_L(0); PG8_BAR; PG8_MMA(1, 0, At, B0); PG8_MMA(1, 1, At, B1); PG8_BAR; PG8_SCHED;
            } else {
            PG8_LDB(B0, 0, 0); PG8_SCHED; PG8_LDA(At, 0, 0); PG8_STAGE(PG8_SA(1, 1), a1 + hstep, voffA);
            PG8_WAIT_L(8); PG8_BAR; PG8_WAIT_L(0); PG8_MMA(0, 0, At, B0); PG8_BAR; PG8_SCHED;
            PG8_LDB(B1, 0, 1); PG8_STAGE(PG8_SB(0, 0), b2, voffB);
            PG8_BAR; PG8_WAIT_L(0); PG8_MMA(0, 1, At, B1); PG8_BAR;
            PG8_LDA(At, 0, 1); PG8_STAGE(PG8_SA(0, 0), a2, voffA);
            PG8_BAR; PG8_WAIT_L(0); PG8_MMA(1, 0, At, B0); PG8_BAR; PG8_SCHED;
            PG8_STAGE(PG8_SB(0, 1), b2 + hstep, voffB);
            PG8_WAIT_V(6); PG8_BAR; PG8_MMA(1, 1, At, B1); PG8_BAR;
            PG8_LDB(B0, 1, 0); PG8_SCHED; PG8_LDA(At, 1, 0); PG8_STAGE(PG8_SA(0, 1), a2 + hstep, voffA);
            PG8_WAIT_L(8); PG8_BAR; PG8_WAIT_L(0); PG8_MMA(0, 0, At, B0); PG8_BAR; PG8_SCHED;
            PG8_LDB(B1, 1, 1); PG8_STAGE(PG8_SB(1, 0), b3, voffB);
            PG8_BAR; PG8_WAIT_L(0); PG8_MMA(0, 1, At, B1); PG8_BAR;
            PG8_LDA(At, 1, 1); PG8_STAGE(PG8_SA(1, 0), a3, voffA);
            PG8_BAR; PG8_WAIT_L(0); PG8_MMA(1, 0, At, B0); PG8_BAR; PG8_SCHED;
            PG8_STAGE(PG8_SB(1, 1), b3 + hstep, voffB);
            PG8_WAIT_V(6); PG8_BAR; PG8_MMA(1, 1, At, B1); PG8_BAR;
            }
        }
        if constexpr (ALIGN_EPI) { if (wr == 0) PG8_BAR; }
        if constexpr (!Epi::AFTER_DRAIN) { E(acc, cur, wr, wc, fr, fq); S.done(cur); }
        if (!has_next) break;
#pragma unroll
        for (int a = 0; a < 2; ++a)
#pragma unroll
            for (int b = 0; b < 2; ++b)
#pragma unroll
                for (int m = 0; m < 4; ++m)
#pragma unroll
                    for (int n = 0; n < 2; ++n) acc[a][b][m][n] = (f32x4){0.f, 0.f, 0.f, 0.f};
        cur = nxt; cA = nA; cB = nB; ++ui;
        if constexpr (ALIGN_EPI) { if (wr == 1) PG8_BAR; }
    }
    PG8_WAIT_V(0);
    if constexpr (!ALIGN_EPI) { if (wr == 0) PG8_BAR; }
    PG8_BAR;
    if constexpr (Epi::AFTER_DRAIN) { E.fused(acc, cur, wr, wc, fr, fq, lds, wid, lane); S.done(cur); }
#undef PG8_SA
#undef PG8_SB
#undef PG8_STAGE
#undef PG8_LDA
#undef PG8_LDB
#undef PG8_MMA
#undef PG8_WAIT_V
#undef PG8_WAIT_L
#undef PG8_BAR
#undef PG8_SCHED
}
}

constexpr int D = 1024, MP = 16384, MS = 128, MT = MP + MS, SEQ = 2048, NBATCH = 8, FF = 4096;
constexpr int NZ = 2560;
constexpr int INC = 2568;
constexpr int NMOD = 136, NMODP = 144, MODC = 6144;
constexpr int NCH = 32;
constexpr int NITEM = 1024;
constexpr float EPS = 1e-6f;
constexpr float KSCALE = 0.08838834764831845f;

constexpr size_t MiB = 1u << 20;
constexpr size_t WS_WIN = 2 * MiB, WS_WOUT = 7 * MiB, WS_WUP = 9 * MiB, WS_WDN = 17 * MiB, WS_WADA = 25 * MiB, WS_WPOOL = 37 * MiB;
constexpr size_t WS_SILU = 37 * MiB + 256 * 1024, WS_MOD = 38 * MiB, WS_GATES = 42 * MiB;
constexpr size_t WS_CHB = 43 * MiB, WS_CHM = WS_CHB + 4096, WS_MST = WS_CHM + 4096, WS_NU = 43 * MiB + 256 * 1024, WS_NST = 43 * MiB + 768 * 1024;
constexpr size_t WS_H = 45 * MiB;
constexpr size_t WS_Z = 78 * MiB;
constexpr size_t WS_U = 159 * MiB;
constexpr size_t WS_CST = 223 * MiB;
constexpr size_t WS_T1 = 78 * MiB;
constexpr size_t WS_F = 78 * MiB;
constexpr size_t WS_T2 = 208 * MiB;
static_assert(WS_NST + 512 * 1024 <= WS_H && WS_H + (size_t)MT * D * 2 <= WS_Z && WS_Z + (size_t)MT * NZ * 2 <= WS_U && WS_CST + 32 * MiB <= 256 * MiB, "ws map");
static_assert(WS_F + (size_t)MT * FF * 2 <= WS_T2 && WS_T2 + (size_t)MT * D * 2 <= 256 * MiB && WS_T1 + (size_t)MT * D * 4 <= WS_U, "ws map 2");

constexpr size_t O_YP = 0, O_YS = 16777216, O_CP = 16908288, O_NP = 17432576, O_MP = 17436672, O_PP = 17436704, O_CS = 17498144, O_NS = 25886752, O_MS = 25952288, O_PS = 25952800, O_END = 26935840;

constexpr int LDS_BYTES = 147456;
constexpr int NWAVES = 8;

typedef unsigned short bf16;
typedef unsigned u32x4 __attribute__((ext_vector_type(4)));
typedef unsigned u32x2 __attribute__((ext_vector_type(2)));
typedef float f32x4 __attribute__((ext_vector_type(4)));
typedef short bf16x8 __attribute__((ext_vector_type(8)));

struct Args {
    const float *x_prompt, *x_sample, *c_prompt, *c_sample, *state_C, *state_n, *state_m, *state_pool, *w_ada, *b_ada, *g_pre1, *g_post1, *w_in, *b_ig, *b_fg, *g_head, *w_pool,
        *pool_scale, *w_out, *g_pre2, *g_post2, *w_up, *w_down;
    float* out; unsigned char* ws;
    int ph_lo, ph_hi;
};

__device__ __forceinline__ unsigned f2bf(float f) { unsigned u = __builtin_bit_cast(unsigned, f); return (u + 0x7fffu + ((u >> 16) & 1u)) >> 16; }
__device__ __forceinline__ unsigned pk2(float lo, float hi) { return f2bf(lo) | (f2bf(hi) << 16); }
__device__ __forceinline__ float bf2f(unsigned h) { return __builtin_bit_cast(float, h << 16); }
__device__ __forceinline__ float bflo(unsigned w) { return __builtin_bit_cast(float, w << 16); }
__device__ __forceinline__ float bfhi(unsigned w) { return __builtin_bit_cast(float, w & 0xffff0000u); }
__device__ __forceinline__ float wave_sum(float v) {
#pragma unroll
    for (int o = 1; o < 64; o <<= 1) v += __shfl_xor(v, o);
    return v;
}
__device__ __forceinline__ float wave_max(float v) {
#pragma unroll
    for (int o = 1; o < 64; o <<= 1) v = fmaxf(v, __shfl_xor(v, o));
    return v;
}
__device__ __forceinline__ float sigmoidf_(float x) { return 1.f / (1.f + __expf(-x)); }
__device__ __forceinline__ int mod_row(int row) { return row < MP ? (row >> 11) : (NBATCH + row - MP); }
__device__ __forceinline__ f32x4 mfma16(bf16x8 a, bf16x8 b, f32x4 c) { return __builtin_amdgcn_mfma_f32_16x16x32_bf16(a, b, c, 0, 0, 0); }

__device__ __forceinline__ void transpose_item(const float* W, int ldw, int nblk, int K, bf16* WT, float* scr, int item, int lane, float scale) {
    const int kb = item / nblk, nb = item % nblk, k0 = 64 * kb, n0 = 32 * nb;
#pragma unroll 8
    for (int i = 0; i < 32; ++i) { const int kk = 2 * i + (lane >> 5); scr[kk * 33 + (lane & 31)] = W[(size_t)(k0 + kk) * ldw + n0 + (lane & 31)] * scale; }
    asm volatile("s_waitcnt lgkmcnt(0)" ::: "memory");
    const int c = lane & 7;
#pragma unroll
    for (int j = 0; j < 4; ++j) { const int n = (lane >> 3) + 8 * j; const float* s = scr + (8 * c) * 33 + n;
        u32x4 o; o.x = pk2(s[0 * 33], s[1 * 33]); o.y = pk2(s[2 * 33], s[3 * 33]); o.z = pk2(s[4 * 33], s[5 * 33]); o.w = pk2(s[6 * 33], s[7 * 33]);
        *(u32x4*)(WT + (size_t)(n0 + n) * K + k0 + 8 * c) = o; }
    asm volatile("s_waitcnt lgkmcnt(0)" ::: "memory");
}

__device__ __forceinline__ void phase0(const Args& a, unsigned char* lds, int gw, int NGW, int lane, int wave) {
    float* scr = (float*)(lds + wave * 16384);
    unsigned char* ws = a.ws;
    constexpr int I_INA = 16 * 64, I_INB = 16 * 16, I_OUT = 16 * 32, I_UP = 16 * 128, I_DN = 64 * 32, I_ADA = 16 * 192, I_POOL = 32;
    constexpr int NIT = I_INA + I_INB + I_OUT + I_UP + I_DN + I_ADA + I_POOL;
    for (int it = gw; it < NIT; it += NGW) {
        int r = it;
        if (r < I_INA) { const int nb = r % 64; const float sc = (nb >= 16 && nb < 32) ? KSCALE : 1.f; transpose_item(a.w_in, INC, 64, D, (bf16*)(ws + WS_WIN), scr, r, lane, sc); continue; } r -= I_INA;
        if (r < I_INB) { transpose_item(a.w_in + 2056, INC, 16, D, (bf16*)(ws + WS_WIN) + (size_t)2048 * D, scr, r, lane, 1.f); continue; } r -= I_INB;
        if (r < I_OUT) { transpose_item(a.w_out, D, 32, D, (bf16*)(ws + WS_WOUT), scr, r, lane, 1.f); continue; } r -= I_OUT;
        if (r < I_UP) { transpose_item(a.w_up, FF, 128, D, (bf16*)(ws + WS_WUP), scr, r, lane, 1.f); continue; } r -= I_UP;
        if (r < I_DN) { transpose_item(a.w_down, D, 32, FF, (bf16*)(ws + WS_WDN), scr, r, lane, 1.f); continue; } r -= I_DN;
        if (r < I_ADA) { transpose_item(a.w_ada, MODC, 192, D, (bf16*)(ws + WS_WADA), scr, r, lane, 1.f); continue; } r -= I_ADA;
        { const int g = r >> 3; transpose_item(a.w_pool + g * 16384, 128, 4, 128, (bf16*)(ws + WS_WPOOL) + g * 16384, scr, r & 7, lane, 1.f); }
    }
    bf16* S = (bf16*)(ws + WS_SILU);
    for (int i = gw * 64 + lane; i < NMODP * D; i += NGW * 64) {
        const int row = i >> 10, col = i & 1023; float v = 0.f;
        if (row < NBATCH) v = a.c_prompt[row * D + col]; else if (row < NMOD) v = a.c_sample[(row - NBATCH) * D + col];
        S[i] = (bf16)f2bf(v * sigmoidf_(v));
    }
}

template <int MODE> __device__ __forceinline__ void small_gemm(const bf16* A, const bf16* Bt, int N, int K, int Mtiles, int gw, int NGW, int lane, void* outp, const float* bias) {
    const int fr = lane & 15, fq = lane >> 4;
    const int ntile = Mtiles * (N >> 4);
    for (int tile = gw; tile < ntile; tile += NGW) {
        const int mt = tile % Mtiles, nt = tile / Mtiles;
        const bf16* ap = A + (size_t)(mt * 16 + fr) * K + fq * 8;
        const bf16* bp = Bt + (size_t)(nt * 16 + fr) * K + fq * 8;
        f32x4 acc = (f32x4){0.f, 0.f, 0.f, 0.f};
#pragma unroll 8
        for (int k = 0; k < K; k += 32) { const bf16x8 av = *(const bf16x8*)(ap + k); const bf16x8 bv = *(const bf16x8*)(bp + k); acc = mfma16(av, bv, acc); }
        const int col = nt * 16 + fr;
#pragma unroll
        for (int j = 0; j < 4; ++j) { const int row = mt * 16 + fq * 4 + j; const float v = acc[j];
            if (MODE == 0) { if (row < NMOD) ((float*)outp)[(size_t)row * MODC + col] = v + bias[col]; }
            else if (MODE == 1) ((bf16*)outp)[(size_t)row * NZ + col] = (bf16)f2bf(v);
            else if (MODE == 2) ((float*)outp)[(size_t)row * D + col] = v;
            else if (MODE == 3) { const float r = fmaxf(v, 0.f); ((bf16*)outp)[(size_t)row * FF + col] = (bf16)f2bf(r * r); }
            else ((bf16*)outp)[(size_t)row * D + col] = (bf16)f2bf(v); }
    }
}

__device__ __forceinline__ void phase1a(const Args& a, unsigned char* lds, int gw, int NGW, int lane, int tid) {
    f32x4* wg4 = (f32x4*)lds;
    for (int i = tid; i < 2048; i += 512) { const int k = i >> 1, hf = i & 1; wg4[i] = *(const f32x4*)(a.w_in + (size_t)k * INC + 2048 + hf * 4); }
    __syncthreads();
    const float* MOD = (const float*)(a.ws + WS_MOD); bf16* HN = (bf16*)(a.ws + WS_H); float* GATES = (float*)(a.ws + WS_GATES);
    for (int row = gw; row < MT; row += NGW) {
        const float* xr = row < MP ? a.x_prompt + (size_t)row * D : a.x_sample + (size_t)(row - MP) * D;
        const float* md = MOD + (size_t)mod_row(row) * MODC;
        f32x4 v[4]; float ss = 0.f;
#pragma unroll
        for (int j = 0; j < 4; ++j) { v[j] = *(const f32x4*)(xr + j * 256 + lane * 4); ss += (v[j][0] * v[j][0] + v[j][1] * v[j][1]) + (v[j][2] * v[j][2] + v[j][3] * v[j][3]); }
        const float rstd = rsqrtf(wave_sum(ss) * (1.f / D) + EPS);
        float g0 = 0.f, g1 = 0.f, g2 = 0.f, g3 = 0.f, g4 = 0.f, g5 = 0.f, g6 = 0.f, g7 = 0.f;
#pragma unroll
        for (int j = 0; j < 4; ++j) { const int col = j * 256 + lane * 4;
            const f32x4 gp = *(const f32x4*)(a.g_pre1 + col), sh = *(const f32x4*)(md + col), sc = *(const f32x4*)(md + D + col);
            f32x4 h = v[j] * rstd * gp * (sc + 1.f) + sh;
            u32x2 o; o.x = pk2(h[0], h[1]); o.y = pk2(h[2], h[3]); *(u32x2*)(HN + (size_t)row * D + col) = o;
#pragma unroll
            for (int i = 0; i < 4; ++i) { const f32x4 w0 = wg4[(col + i) * 2], w1 = wg4[(col + i) * 2 + 1]; const float hv = h[i];
                g0 += hv * w0[0]; g1 += hv * w0[1]; g2 += hv * w0[2]; g3 += hv * w0[3]; g4 += hv * w1[0]; g5 += hv * w1[1]; g6 += hv * w1[2]; g7 += hv * w1[3]; } }
        g0 = wave_sum(g0); g1 = wave_sum(g1); g2 = wave_sum(g2); g3 = wave_sum(g3); g4 = wave_sum(g4); g5 = wave_sum(g5); g6 = wave_sum(g6); g7 = wave_sum(g7);
        if (lane == 0) {
            f32x4 ig = (f32x4){g0 + a.b_ig[0], g1 + a.b_ig[1], g2 + a.b_ig[2], g3 + a.b_ig[3]};
            f32x4 fg = (f32x4){g4 + a.b_fg[0], g5 + a.b_fg[1], g6 + a.b_fg[2], g7 + a.b_fg[3]}; f32x4 lf;
#pragma unroll
            for (int i = 0; i < 4; ++i) lf[i] = fminf(fg[i], 0.f) - log1pf(expf(-fabsf(fg[i])));
            *(f32x4*)(GATES + (size_t)row * 8) = ig; *(f32x4*)(GATES + (size_t)row * 8 + 4) = lf;
        }
    }
    __syncthreads();
}

__device__ __forceinline__ void p2_chunk_item(const Args& a, unsigned char* lds, int it, int tid, int lane, int wave) {
    const int bh = it >> 5, c = it & 31, b = bh >> 2, h = bh & 3, r0 = b * SEQ + c * 64;
    const bf16* Z = (const bf16*)(a.ws + WS_Z); const float* GATES = (const float*)(a.ws + WS_GATES);
    float* wLs = (float*)lds; bf16* KT = (bf16*)(lds + 1024); bf16* VT = (bf16*)(lds + 1024 + 18432);
    if (wave == 0) {
        const float lf = GATES[(size_t)(r0 + lane) * 8 + 4 + h], ig = GATES[(size_t)(r0 + lane) * 8 + h];
        float bs = lf;
#pragma unroll
        for (int o = 1; o < 64; o <<= 1) { const float t = __shfl_up(bs, o); if (lane >= o) bs += t; }
        const float B = __shfl(bs, 63); const float val = B - bs + ig; const float mloc = wave_max(val);
        wLs[lane] = __expf(val - mloc);
        if (lane == 0) { ((float*)(a.ws + WS_CHB))[it] = B; ((float*)(a.ws + WS_CHM))[it] = mloc; }
    }
    __syncthreads();
#pragma unroll
    for (int rep = 0; rep < 2; ++rep) { const int idx = tid + rep * 512, s = idx >> 4, dv = idx & 15;
        const u32x4 kv = *(const u32x4*)(Z + (size_t)(r0 + s) * NZ + 512 + h * 128 + dv * 8); const u32x4 vv = *(const u32x4*)(Z + (size_t)(r0 + s) * NZ + 1024 + h * 128 + dv * 8);
        const float w = wLs[s];
#pragma unroll
        for (int j = 0; j < 4; ++j) { KT[(dv * 8 + 2 * j) * 72 + s] = (bf16)f2bf(bflo(kv[j]) * w); KT[(dv * 8 + 2 * j + 1) * 72 + s] = (bf16)f2bf(bfhi(kv[j]) * w);
            VT[(dv * 8 + 2 * j) * 72 + s] = (bf16)(vv[j] & 0xffffu); VT[(dv * 8 + 2 * j + 1) * 72 + s] = (bf16)(vv[j] >> 16); } }
    __syncthreads();
    const int fr = lane & 15, fq = lane >> 4;
    float* U = (float*)(a.ws + WS_U) + (size_t)it * 16384;
    const bf16x8 a0 = *(const bf16x8*)(VT + (wave * 16 + fr) * 72 + fq * 8), a1 = *(const bf16x8*)(VT + (wave * 16 + fr) * 72 + 32 + fq * 8);
#pragma unroll
    for (int dt = 0; dt < 8; ++dt) { const bf16x8 b0 = *(const bf16x8*)(KT + (dt * 16 + fr) * 72 + fq * 8), b1 = *(const bf16x8*)(KT + (dt * 16 + fr) * 72 + 32 + fq * 8);
        f32x4 acc = mfma16(a0, b0, (f32x4){0.f, 0.f, 0.f, 0.f}); acc = mfma16(a1, b1, acc);
#pragma unroll
        for (int j = 0; j < 4; ++j) U[(wave * 16 + fq * 4 + j) * 128 + dt * 16 + fr] = acc[j]; }
    if (tid < 128) { float s = 0.f;
        for (int i = 0; i < 64; ++i) s += bf2f(KT[tid * 72 + i]);
        ((float*)(a.ws + WS_NU))[(size_t)it * 128 + tid] = s; }
    __syncthreads();
}

__device__ __forceinline__ void pool_mma(const Args& a, const bf16* Ps, int gi, int rowbase, int lane, int wave) {
    const int fr = lane & 15, fq = lane >> 4, tt = wave & 3, dh = wave >> 2;
    const bf16* WP = (const bf16*)(a.ws + WS_WPOOL) + gi * 16384; bf16* MIX = (bf16*)(a.ws + WS_H);
    bf16x8 pa[4];
#pragma unroll
    for (int ks = 0; ks < 4; ++ks) pa[ks] = *(const bf16x8*)(Ps + (tt * 16 + fr) * 136 + ks * 32 + fq * 8);
#pragma unroll
    for (int i = 0; i < 4; ++i) { const int dt = dh * 4 + i; f32x4 acc = (f32x4){0.f, 0.f, 0.f, 0.f};
#pragma unroll
        for (int ks = 0; ks < 4; ++ks) { const bf16x8 wb = *(const bf16x8*)(WP + (dt * 16 + fr) * 128 + ks * 32 + fq * 8); acc = mfma16(pa[ks], wb, acc); }
        const int dcol = dt * 16 + fr; const float sc = a.pool_scale[gi * 128 + dcol];
#pragma unroll
        for (int j = 0; j < 4; ++j) MIX[(size_t)(rowbase + tt * 16 + fq * 4 + j) * D + 512 + gi * 128 + dcol] = (bf16)f2bf(acc[j] * sc); }
}

__device__ __forceinline__ void p2_pool_prompt_item(const Args& a, unsigned char* lds, int itp, int tid, int lane, int wave) {
    const int b = itp >> 5, tile = itp & 31, t0 = tile * 64, r0 = b * SEQ + t0;
    const bf16* Z = (const bf16*)(a.ws + WS_Z);
    bf16* Us = (bf16*)lds; bf16* Ps = (bf16*)(lds + 20480);
    for (int gi = 0; gi < 4; ++gi) {
        for (int idx = tid; idx < 79 * 16; idx += 512) { const int i = idx >> 4, cv = idx & 15, t = t0 - 15 + i;
            u32x4 val = (u32x4){0u, 0u, 0u, 0u};
            if (t >= 0) val = *(const u32x4*)(Z + (size_t)(b * SEQ + t) * NZ + 2048 + gi * 128 + cv * 8);
            *(u32x4*)(Us + i * 128 + cv * 8) = val; }
        __syncthreads();
        const int win = 2 << gi;
#pragma unroll
        for (int rep = 0; rep < 2; ++rep) { const int idx = tid + rep * 512, tl = idx >> 4, cv = idx & 15, t = t0 + tl;
            const float inv = 1.f / (float)min(t + 1, win);
            float s0 = 0.f, s1 = 0.f, s2 = 0.f, s3 = 0.f, s4 = 0.f, s5 = 0.f, s6 = 0.f, s7 = 0.f;
            for (int jj = 0; jj < win; ++jj) { const u32x4 w = *(const u32x4*)(Us + (tl + 15 - jj) * 128 + cv * 8);
                s0 += bflo(w[0]); s1 += bfhi(w[0]); s2 += bflo(w[1]); s3 += bfhi(w[1]); s4 += bflo(w[2]); s5 += bfhi(w[2]); s6 += bflo(w[3]); s7 += bfhi(w[3]); }
            const u32x4 uu = *(const u32x4*)(Us + (tl + 15) * 128 + cv * 8);
            u32x4 o; o.x = pk2(s0 * inv - bflo(uu[0]), s1 * inv - bfhi(uu[0])); o.y = pk2(s2 * inv - bflo(uu[1]), s3 * inv - bfhi(uu[1]));
            o.z = pk2(s4 * inv - bflo(uu[2]), s5 * inv - bfhi(uu[2])); o.w = pk2(s6 * inv - bflo(uu[3]), s7 * inv - bfhi(uu[3]));
            *(u32x4*)(Ps + tl * 136 + cv * 8) = o; }
        __syncthreads();
        pool_mma(a, Ps, gi, r0, lane, wave);
        if (tile == 31) { float* PP = a.out + O_PP;
            for (int idx = tid; idx < 15 * 128; idx += 512) { const int i = idx >> 7, cc = idx & 127; PP[(size_t)(b * 15 + i) * 512 + gi * 128 + cc] = bf2f(Us[(64 + i) * 128 + cc]); } }
        __syncthreads();
    }
}

__device__ __forceinline__ void p2_pool_sample_item(const Args& a, unsigned char* lds, int tile, int tid, int lane, int wave) {
    const bf16* Z = (const bf16*)(a.ws + WS_Z);
    bf16* Ps = (bf16*)(lds + 20480);
    for (int gi = 0; gi < 4; ++gi) {
        const int win = 2 << gi; const float inv = 1.f / (float)win;
#pragma unroll
        for (int rep = 0; rep < 2; ++rep) { const int idx = tid + rep * 512, tl = idx >> 4, cv = idx & 15, bsi = tile * 64 + tl;
            const u32x4 uu = *(const u32x4*)(Z + (size_t)(MP + bsi) * NZ + 2048 + gi * 128 + cv * 8);
            float s0 = bflo(uu[0]), s1 = bfhi(uu[0]), s2 = bflo(uu[1]), s3 = bfhi(uu[1]), s4 = bflo(uu[2]), s5 = bfhi(uu[2]), s6 = bflo(uu[3]), s7 = bfhi(uu[3]);
            for (int jj = 1; jj < win; ++jj) { const float* sp = a.state_pool + (size_t)(bsi * 15 + 15 - jj) * 512 + gi * 128 + cv * 8;
                const f32x4 p0 = *(const f32x4*)sp, p1 = *(const f32x4*)(sp + 4);
                s0 += p0[0]; s1 += p0[1]; s2 += p0[2]; s3 += p0[3]; s4 += p1[0]; s5 += p1[1]; s6 += p1[2]; s7 += p1[3]; }
            u32x4 o; o.x = pk2(s0 * inv - bflo(uu[0]), s1 * inv - bfhi(uu[0])); o.y = pk2(s2 * inv - bflo(uu[1]), s3 * inv - bfhi(uu[1]));
            o.z = pk2(s4 * inv - bflo(uu[2]), s5 * inv - bfhi(uu[2])); o.w = pk2(s6 * inv - bflo(uu[3]), s7 * inv - bfhi(uu[3]));
            *(u32x4*)(Ps + tl * 136 + cv * 8) = o; }
        __syncthreads();
        pool_mma(a, Ps, gi, MP + tile * 64, lane, wave);
        __syncthreads();
    }
}

__device__ __forceinline__ void p2_sample_item(const Args& a, unsigned char* lds, int it2, int tid, int lane, int wave) {
    const int bs = it2 >> 2, h = it2 & 3, r = MP + bs, sh = bs * 4 + h;
    const bf16* Z = (const bf16*)(a.ws + WS_Z); const float* GATES = (const float*)(a.ws + WS_GATES); bf16* MIX = (bf16*)(a.ws + WS_H);
    float* qs = (float*)lds; float* ks = qs + 128; float* vs = qs + 256; float* scal = qs + 384; float* hs = qs + 512; float* red = qs + 1024;
    if (tid < 128) { qs[tid] = bf2f(Z[(size_t)r * NZ + h * 128 + tid]); ks[tid] = bf2f(Z[(size_t)r * NZ + 512 + h * 128 + tid]); vs[tid] = bf2f(Z[(size_t)r * NZ + 1024 + h * 128 + tid]); }
    __syncthreads();
    if (wave == 0) {
        const float n0a = a.state_n[(size_t)sh * 128 + lane], n0b = a.state_n[(size_t)sh * 128 + 64 + lane];
        const float qk = wave_sum(qs[lane] * ks[lane] + qs[lane + 64] * ks[lane + 64]);
        const float qn = wave_sum(qs[lane] * n0a + qs[lane + 64] * n0b);
        const float ig = GATES[(size_t)r * 8 + h], lf = GATES[(size_t)r * 8 + 4 + h], m0 = a.state_m[sh];
        const float g = lf + m0, m = fmaxf(g, ig), w = __expf(ig - m), al = __expf(g - m);
        const float s = qk * w, den = al * qn + s, dn = fmaxf(fabsf(den), __expf(-m));
        if (lane == 0) { scal[0] = al; scal[1] = w; scal[2] = s; scal[3] = dn; a.out[O_MS + sh] = m; }
        a.out[O_NS + (size_t)sh * 128 + lane] = al * n0a + w * ks[lane]; a.out[O_NS + (size_t)sh * 128 + 64 + lane] = al * n0b + w * ks[lane + 64];
    }
    __syncthreads();
    {
        const int e4 = (tid & 31) * 4, dg = tid >> 5; const float al = scal[0], w = scal[1];
        const f32x4 v4 = *(const f32x4*)(vs + e4); f32x4 part = (f32x4){0.f, 0.f, 0.f, 0.f};
        const float* C0 = a.state_C + (size_t)sh * 16384; float* C1 = a.out + O_CS + (size_t)sh * 16384;
#pragma unroll
        for (int dd = 0; dd < 8; ++dd) { const int d = dg * 8 + dd; const f32x4 c0 = *(const f32x4*)(C0 + d * 128 + e4);
            part += c0 * qs[d]; *(f32x4*)(C1 + d * 128 + e4) = c0 * al + v4 * (w * ks[d]); }
        *(f32x4*)(red + dg * 128 + e4) = part;
    }
    __syncthreads();
    if (tid < 128) { float qc = 0.f;
#pragma unroll
        for (int dg = 0; dg < 16; ++dg) qc += red[dg * 128 + tid];
        hs[tid] = (scal[0] * qc + scal[2] * vs[tid]) / scal[3]; }
    __syncthreads();
    if (wave == 0) {
        const float h0 = hs[lane], h1 = hs[lane + 64];
        const float rstd = rsqrtf(wave_sum(h0 * h0 + h1 * h1) * (1.f / 128.f) + EPS);
        const float o0 = bf2f(Z[(size_t)r * NZ + 1536 + h * 128 + lane]), o1 = bf2f(Z[(size_t)r * NZ + 1536 + h * 128 + 64 + lane]);
        MIX[(size_t)r * D + h * 128 + lane] = (bf16)f2bf(h0 * rstd * a.g_head[lane] * sigmoidf_(o0));
        MIX[(size_t)r * D + h * 128 + 64 + lane] = (bf16)f2bf(h1 * rstd * a.g_head[lane + 64] * sigmoidf_(o1));
    }
    for (int idx = tid; idx < 15 * 128; idx += 512) { const int i = idx >> 7, cc = h * 128 + (idx & 127);
        a.out[O_PS + (size_t)(bs * 15 + i) * 512 + cc] = i < 14 ? a.state_pool[(size_t)(bs * 15 + i + 1) * 512 + cc] : bf2f(Z[(size_t)r * NZ + 2048 + cc]); }
    __syncthreads();
}

__device__ __forceinline__ void phase2(const Args& a, unsigned char* lds, int tid, int lane, int wave) {
    constexpr int N1 = NITEM, N2 = N1 + 256, N3 = N2 + 2, N4 = N3 + 512;
    for (int it = blockIdx.x; it < N4; it += gridDim.x) {
        if (it < N1) p2_chunk_item(a, lds, it, tid, lane, wave);
        else if (it < N2) p2_pool_prompt_item(a, lds, it - N1, tid, lane, wave);
        else if (it < N3) p2_pool_sample_item(a, lds, it - N2, tid, lane, wave);
        else p2_sample_item(a, lds, it - N3, tid, lane, wave);
    }
}

__device__ __forceinline__ void phase3(const Args& a, int tid) {
    const float* U = (const float*)(a.ws + WS_U); bf16* CST = (bf16*)(a.ws + WS_CST);
    const float* CHB = (const float*)(a.ws + WS_CHB); const float* CHM = (const float*)(a.ws + WS_CHM); float* MST = (float*)(a.ws + WS_MST);
    const float* NU = (const float*)(a.ws + WS_NU); float* NST = (float*)(a.ws + WS_NST);
    for (int idx = blockIdx.x * 512 + tid; idx < 32 * 4096; idx += gridDim.x * 512) {
        const int bh = idx >> 12, rem = idx & 4095, e = rem >> 5, d4 = (rem & 31) * 4;
        f32x4 C = (f32x4){0.f, 0.f, 0.f, 0.f}; float m = 0.f, nacc = 0.f;
#pragma unroll 4
        for (int c = 0; c < NCH; ++c) { const int it = bh * 32 + c;
            const f32x4 u = *(const f32x4*)(U + (size_t)it * 16384 + e * 128 + d4);
            u32x2 o; o.x = pk2(C[0], C[1]); o.y = pk2(C[2], C[3]); *(u32x2*)(CST + (size_t)it * 16384 + e * 128 + d4) = o;
            float nu = 0.f;
            if (rem < 128) { NST[(size_t)it * 128 + rem] = nacc; nu = NU[(size_t)it * 128 + rem]; }
            if (rem == 0) MST[it] = m;
            const float B = CHB[it], ml = CHM[it], m2 = fmaxf(B + m, ml), al = __expf(B + m - m2), be = __expf(ml - m2);
            C = C * al + u * be; nacc = al * nacc + be * nu; m = m2; }
        float* CP = a.out + O_CP + (size_t)bh * 16384;
#pragma unroll
        for (int i = 0; i < 4; ++i) CP[(d4 + i) * 128 + e] = C[i];
        if (rem < 128) a.out[O_NP + (size_t)bh * 128 + rem] = nacc;
        if (rem == 0) a.out[O_MP + bh] = m;
    }
}

__device__ __forceinline__ void p4_item(const Args& a, unsigned char* lds, int it, int tid, int lane, int wave) {
    const int bh = it >> 5, c = it & 31, b = bh >> 2, h = bh & 3, r0 = b * SEQ + c * 64;
    const bf16* Z = (const bf16*)(a.ws + WS_Z); const float* GATES = (const float*)(a.ws + WS_GATES); bf16* MIX = (bf16*)(a.ws + WS_H);
    const bf16* CST = (const bf16*)(a.ws + WS_CST) + (size_t)it * 16384;
    float* bsA = (float*)lds; float* csA = bsA + 64; float* msA = bsA + 128; float* aA = bsA + 192; float* dnA = bsA + 256; float* n0s = bsA + 320;
    bf16* VT = (bf16*)(lds + 2048); bf16* Ss = (bf16*)(lds + 20480); float* Hs = (float*)(lds + 29696);
    const int fr = lane & 15, fq = lane >> 4, tt = wave & 3, eh = wave >> 2;
    if (wave == 0) {
        const float lf = GATES[(size_t)(r0 + lane) * 8 + 4 + h], ig = GATES[(size_t)(r0 + lane) * 8 + h];
        float bs = lf;
#pragma unroll
        for (int o = 1; o < 64; o <<= 1) { const float t = __shfl_up(bs, o); if (lane >= o) bs += t; }
        const float cs = ig - bs; float pm = cs;
#pragma unroll
        for (int o = 1; o < 64; o <<= 1) { const float t = __shfl_up(pm, o); if (lane >= o) pm = fmaxf(pm, t); }
        const float m0 = ((const float*)(a.ws + WS_MST))[it];
        const float mt = bs + fmaxf(m0, pm);
        bsA[lane] = bs; csA[lane] = cs; msA[lane] = mt; aA[lane] = __expf(bs + m0 - mt);
    }
    if (tid >= 128 && tid < 256) n0s[tid - 128] = ((const float*)(a.ws + WS_NST))[(size_t)it * 128 + tid - 128];
#pragma unroll
    for (int rep = 0; rep < 2; ++rep) { const int idx = tid + rep * 512, s = idx >> 4, dv = idx & 15;
        const u32x4 vv = *(const u32x4*)(Z + (size_t)(r0 + s) * NZ + 1024 + h * 128 + dv * 8);
#pragma unroll
        for (int j = 0; j < 4; ++j) { VT[(dv * 8 + 2 * j) * 72 + s] = (bf16)(vv[j] & 0xffffu); VT[(dv * 8 + 2 * j + 1) * 72 + s] = (bf16)(vv[j] >> 16); } }
    bf16x8 qa[4];
#pragma unroll
    for (int ks = 0; ks < 4; ++ks) qa[ks] = *(const bf16x8*)(Z + (size_t)(r0 + tt * 16 + fr) * NZ + h * 128 + ks * 32 + fq * 8);
    __syncthreads();
#pragma unroll
    for (int si = 0; si < 2; ++si) { const int st = eh * 2 + si; f32x4 acc = (f32x4){0.f, 0.f, 0.f, 0.f};
#pragma unroll
        for (int ks = 0; ks < 4; ++ks) { const bf16x8 kb = *(const bf16x8*)(Z + (size_t)(r0 + st * 16 + fr) * NZ + 512 + h * 128 + ks * 32 + fq * 8); acc = mfma16(qa[ks], kb, acc); }
        const int sidx = st * 16 + fr; const float cs = csA[sidx];
#pragma unroll
        for (int j = 0; j < 4; ++j) { const int t = tt * 16 + fq * 4 + j; const float wgt = (sidx <= t) ? __expf(bsA[t] + cs - msA[t]) : 0.f;
            Ss[t * 72 + sidx] = (bf16)f2bf(acc[j] * wgt); } }
    __syncthreads();
    { const int t = tid >> 3, sub = tid & 7;
        const u32x4 q0 = *(const u32x4*)(Z + (size_t)(r0 + t) * NZ + h * 128 + sub * 16), q1 = *(const u32x4*)(Z + (size_t)(r0 + t) * NZ + h * 128 + sub * 16 + 8);
        const float* nn = n0s + sub * 16; float qn = 0.f;
#pragma unroll
        for (int j = 0; j < 4; ++j) { qn += bflo(q0[j]) * nn[2 * j] + bfhi(q0[j]) * nn[2 * j + 1]; qn += bflo(q1[j]) * nn[8 + 2 * j] + bfhi(q1[j]) * nn[8 + 2 * j + 1]; }
        const u32x4 sv = *(const u32x4*)(Ss + t * 72 + sub * 8); float ssum = 0.f;
#pragma unroll
        for (int j = 0; j < 4; ++j) ssum += bflo(sv[j]) + bfhi(sv[j]);
        qn += __shfl_xor(qn, 1); qn += __shfl_xor(qn, 2); qn += __shfl_xor(qn, 4);
        ssum += __shfl_xor(ssum, 1); ssum += __shfl_xor(ssum, 2); ssum += __shfl_xor(ssum, 4);
        if (sub == 0) dnA[t] = fmaxf(fabsf(aA[t] * qn + ssum), __expf(-msA[t])); }
    f32x4 num[4];
#pragma unroll
    for (int i = 0; i < 4; ++i) { const int et = eh * 4 + i; f32x4 acc1 = (f32x4){0.f, 0.f, 0.f, 0.f}, acc2 = (f32x4){0.f, 0.f, 0.f, 0.f};
#pragma unroll
        for (int ks = 0; ks < 4; ++ks) { const bf16x8 cb = *(const bf16x8*)(CST + (et * 16 + fr) * 128 + ks * 32 + fq * 8); acc1 = mfma16(qa[ks], cb, acc1); }
#pragma unroll
        for (int ks = 0; ks < 2; ++ks) { const bf16x8 sa = *(const bf16x8*)(Ss + (tt * 16 + fr) * 72 + ks * 32 + fq * 8), vb = *(const bf16x8*)(VT + (et * 16 + fr) * 72 + ks * 32 + fq * 8); acc2 = mfma16(sa, vb, acc2); }
#pragma unroll
        for (int j = 0; j < 4; ++j) num[i][j] = aA[tt * 16 + fq * 4 + j] * acc1[j] + acc2[j]; }
    __syncthreads();
#pragma unroll
    for (int i = 0; i < 4; ++i)
#pragma unroll
        for (int j = 0; j < 4; ++j) { const int t = tt * 16 + fq * 4 + j; Hs[t * 132 + (eh * 4 + i) * 16 + fr] = num[i][j] / dnA[t]; }
    __syncthreads();
    { const int t = tid >> 3, sub = tid & 7, e0 = sub * 16; f32x4 hv[4]; float ss = 0.f;
#pragma unroll
        for (int j = 0; j < 4; ++j) { hv[j] = *(const f32x4*)(Hs + t * 132 + e0 + 4 * j); ss += (hv[j][0] * hv[j][0] + hv[j][1] * hv[j][1]) + (hv[j][2] * hv[j][2] + hv[j][3] * hv[j][3]); }
        ss += __shfl_xor(ss, 1); ss += __shfl_xor(ss, 2); ss += __shfl_xor(ss, 4);
        const float rstd = rsqrtf(ss * (1.f / 128.f) + EPS);
        const u32x4 o0 = *(const u32x4*)(Z + (size_t)(r0 + t) * NZ + 1536 + h * 128 + e0), o1 = *(const u32x4*)(Z + (size_t)(r0 + t) * NZ + 1536 + h * 128 + e0 + 8);
        u32x4 w0, w1;
#pragma unroll
        for (int j = 0; j < 2; ++j) { const f32x4 gh = *(const f32x4*)(a.g_head + e0 + 4 * j);
            w0[2 * j] = pk2(hv[j][0] * rstd * gh[0] * sigmoidf_(bflo(o0[2 * j])), hv[j][1] * rstd * gh[1] * sigmoidf_(bfhi(o0[2 * j])));
            w0[2 * j + 1] = pk2(hv[j][2] * rstd * gh[2] * sigmoidf_(bflo(o0[2 * j + 1])), hv[j][3] * rstd * gh[3] * sigmoidf_(bfhi(o0[2 * j + 1]))); }
#pragma unroll
        for (int j = 0; j < 2; ++j) { const f32x4 gh = *(const f32x4*)(a.g_head + e0 + 8 + 4 * j);
            w1[2 * j] = pk2(hv[2 + j][0] * rstd * gh[0] * sigmoidf_(bflo(o1[2 * j])), hv[2 + j][1] * rstd * gh[1] * sigmoidf_(bfhi(o1[2 * j])));
            w1[2 * j + 1] = pk2(hv[2 + j][2] * rstd * gh[2] * sigmoidf_(bflo(o1[2 * j + 1])), hv[2 + j][3] * rstd * gh[3] * sigmoidf_(bfhi(o1[2 * j + 1]))); }
        *(u32x4*)(MIX + (size_t)(r0 + t) * D + h * 128 + e0) = w0; *(u32x4*)(MIX + (size_t)(r0 + t) * D + h * 128 + e0 + 8) = w1; }
    __syncthreads();
}

__device__ __forceinline__ void phase6(const Args& a, int gw, int NGW, int lane) {
    const float* MOD = (const float*)(a.ws + WS_MOD); const float* T1 = (const float*)(a.ws + WS_T1); bf16* HN = (bf16*)(a.ws + WS_H);
    for (int row = gw; row < MT; row += NGW) {
        const float* xr = row < MP ? a.x_prompt + (size_t)row * D : a.x_sample + (size_t)(row - MP) * D;
        const float* md = MOD + (size_t)mod_row(row) * MODC; const float* tr = T1 + (size_t)row * D; float* orow = a.out + (size_t)row * D;
        f32x4 t[4], x1[4]; float ss = 0.f;
#pragma unroll
        for (int j = 0; j < 4; ++j) { t[j] = *(const f32x4*)(tr + j * 256 + lane * 4); ss += (t[j][0] * t[j][0] + t[j][1] * t[j][1]) + (t[j][2] * t[j][2] + t[j][3] * t[j][3]); }
        const float rstd = rsqrtf(wave_sum(ss) * (1.f / D) + EPS); float ss2 = 0.f;
#pragma unroll
        for (int j = 0; j < 4; ++j) { const int col = j * 256 + lane * 4;
            const f32x4 xv = *(const f32x4*)(xr + col), gp = *(const f32x4*)(a.g_post1 + col), ga = *(const f32x4*)(md + 2 * D + col);
            x1[j] = xv + ga * (t[j] * rstd * gp); *(f32x4*)(orow + col) = x1[j];
            ss2 += (x1[j][0] * x1[j][0] + x1[j][1] * x1[j][1]) + (x1[j][2] * x1[j][2] + x1[j][3] * x1[j][3]); }
        const float rstd2 = rsqrtf(wave_sum(ss2) * (1.f / D) + EPS);
#pragma unroll
        for (int j = 0; j < 4; ++j) { const int col = j * 256 + lane * 4;
            const f32x4 gp = *(const f32x4*)(a.g_pre2 + col), sh = *(const f32x4*)(md + 3 * D + col), sc = *(const f32x4*)(md + 4 * D + col);
            const f32x4 h = x1[j] * rstd2 * gp * (sc + 1.f) + sh;
            u32x2 o; o.x = pk2(h[0], h[1]); o.y = pk2(h[2], h[3]); *(u32x2*)(HN + (size_t)row * D + col) = o; }
    }
}

__device__ __forceinline__ void phase9(const Args& a, int gw, int NGW, int lane) {
    const float* MOD = (const float*)(a.ws + WS_MOD); const bf16* T2 = (const bf16*)(a.ws + WS_T2);
    for (int row = gw; row < MT; row += NGW) {
        const float* md = MOD + (size_t)mod_row(row) * MODC; const bf16* tr = T2 + (size_t)row * D; float* orow = a.out + (size_t)row * D;
        f32x4 t[4]; float ss = 0.f;
#pragma unroll
        for (int j = 0; j < 4; ++j) { const u32x2 w = *(const u32x2*)(tr + j * 256 + lane * 4); t[j] = (f32x4){bflo(w.x), bfhi(w.x), bflo(w.y), bfhi(w.y)};
            ss += (t[j][0] * t[j][0] + t[j][1] * t[j][1]) + (t[j][2] * t[j][2] + t[j][3] * t[j][3]); }
        const float rstd = rsqrtf(wave_sum(ss) * (1.f / D) + EPS);
#pragma unroll
        for (int j = 0; j < 4; ++j) { const int col = j * 256 + lane * 4;
            const f32x4 xv = *(const f32x4*)(orow + col), gp = *(const f32x4*)(a.g_post2 + col), ga = *(const f32x4*)(md + 5 * D + col);
            *(f32x4*)(orow + col) = xv + ga * (t[j] * rstd * gp); }
    }
}

__global__ void __launch_bounds__(NWAVES * 64, 2) mk_fwd(Args a) {
    extern __shared__ __attribute__((aligned(16))) unsigned char lds[];
    cg::grid_group grid = cg::this_grid();
    const int tid = threadIdx.x, lane = tid & 63, wave = __builtin_amdgcn_readfirstlane(tid >> 6);
    const int G = gridDim.x, gw = blockIdx.x * NWAVES + wave, NGW = G * NWAVES;
    const int gwr = (G - 1 - (int)blockIdx.x) * NWAVES + wave;
    PG8_LAS unsigned char* ldsl = (PG8_LAS unsigned char*)lds;
    unsigned char* ws = a.ws;
    const int lo = a.ph_lo, hi = a.ph_hi;
#define IN(k) (lo <= (k) && (k) < hi)
#define SEAM(k) do { if (IN(k) && IN((k) + 1)) grid.sync(); } while (0)

    if (IN(0)) phase0(a, lds, gw, NGW, lane, wave);
    SEAM(0);
    if (IN(1)) small_gemm<0>((const bf16*)(ws + WS_SILU), (const bf16*)(ws + WS_WADA), MODC, D, NMODP / 16, gw, NGW, lane, ws + WS_MOD, a.b_ada);
    SEAM(1);
    if (IN(2)) phase1a(a, lds, gw, NGW, lane, tid);
    SEAM(2);
    if (IN(3)) {
        pg8::Gemm g{(const bf16*)(ws + WS_H), (const bf16*)(ws + WS_WIN), MP, NZ, D}; pg8::StaticOrder S; S.init(MP, NZ, G, (int)blockIdx.x);
        pg8::EpiB16<0> E{(bf16*)(ws + WS_Z), NZ};
        pg8::gemm_phase<pg8::EpiB16<0>, pg8::StaticOrder, true, true>(ldsl, g, S, E);
        small_gemm<1>((const bf16*)(ws + WS_H) + (size_t)MP * D, (const bf16*)(ws + WS_WIN), NZ, D, MS / 16, gwr, NGW, lane, (bf16*)(ws + WS_Z) + (size_t)MP * NZ, nullptr);
    }
    SEAM(3);
    if (IN(4)) phase2(a, lds, tid, lane, wave);
    SEAM(4);
    if (IN(5)) phase3(a, tid);
    SEAM(5);
    if (IN(6)) { for (int it = blockIdx.x; it < NITEM; it += G) p4_item(a, lds, it, tid, lane, wave); }
    SEAM(6);
    if (IN(7)) {
        pg8::Gemm g{(const bf16*)(ws + WS_H), (const bf16*)(ws + WS_WOUT), MP, D, D}; pg8::StaticOrder S; S.init(MP, D, G, (int)blockIdx.x);
        pg8::EpiF32 E{(float*)(ws + WS_T1), D};
        pg8::gemm_phase<pg8::EpiF32, pg8::StaticOrder, false, true>(ldsl, g, S, E);
        small_gemm<2>((const bf16*)(ws + WS_H) + (size_t)MP * D, (const bf16*)(ws + WS_WOUT), D, D, MS / 16, gw, NGW, lane, (float*)(ws + WS_T1) + (size_t)MP * D, nullptr);
    }
    SEAM(7);
    if (IN(8)) phase6(a, gw, NGW, lane);
    SEAM(8);
    if (IN(9)) {
        pg8::Gemm g{(const bf16*)(ws + WS_H), (const bf16*)(ws + WS_WUP), MP, FF, D}; pg8::StaticOrder S; S.init(MP, FF, G, (int)blockIdx.x);
        pg8::EpiB16<1> E{(bf16*)(ws + WS_F), FF};
        pg8::gemm_phase<pg8::EpiB16<1>, pg8::StaticOrder, true, true>(ldsl, g, S, E);
        small_gemm<3>((const bf16*)(ws + WS_H) + (size_t)MP * D, (const bf16*)(ws + WS_WUP), FF, D, MS / 16, gw, NGW, lane, (bf16*)(ws + WS_F) + (size_t)MP * FF, nullptr);
    }
    SEAM(9);
    if (IN(10)) {
        pg8::Gemm g{(const bf16*)(ws + WS_F), (const bf16*)(ws + WS_WDN), MP, D, FF}; pg8::StaticOrder S; S.init(MP, D, G, (int)blockIdx.x);
        pg8::EpiB16<0> E{(bf16*)(ws + WS_T2), D};
        pg8::gemm_phase<pg8::EpiB16<0>, pg8::StaticOrder, false, true>(ldsl, g, S, E);
        small_gemm<4>((const bf16*)(ws + WS_F) + (size_t)MP * FF, (const bf16*)(ws + WS_WDN), D, FF, MS / 16, gw, NGW, lane, (bf16*)(ws + WS_T2) + (size_t)MP * D, nullptr);
    }
    SEAM(10);
    if (IN(11)) phase9(a, gw, NGW, lane);
#undef IN
#undef SEAM
}

#ifndef MK_SPLIT
#define MK_SPLIT 0
#endif
extern "C" void kernel_launch(void* const* d_in, const int* in_sizes, int n_in, void* d_out, int out_size, void* d_ws, size_t ws_size, hipStream_t stream) {
    static int grid = 0;
    if (grid == 0) {
        int dev = 0, cus = 0, per_cu = 0;
        if (hipGetDevice(&dev) != hipSuccess || hipDeviceGetAttribute(&cus, hipDeviceAttributeMultiprocessorCount, dev) != hipSuccess) { fprintf(stderr, "kernel_launch: device query failed\n"); grid = -1; return; }
        if (hipFuncSetAttribute((const void*)mk_fwd, hipFuncAttributeMaxDynamicSharedMemorySize, LDS_BYTES) != hipSuccess) { fprintf(stderr, "kernel_launch: hipFuncSetAttribute failed\n"); grid = -1; return; }
        if (hipOccupancyMaxActiveBlocksPerMultiprocessor(&per_cu, (const void*)mk_fwd, NWAVES * 64, LDS_BYTES) != hipSuccess || per_cu < 1) { fprintf(stderr, "kernel_launch: occupancy query says %d\n", per_cu); per_cu = 1; }
        (void)hipGetLastError();
        grid = cus;
        if (n_in != 23 || out_size != (int)O_END || ws_size < 256 * MiB) fprintf(stderr, "kernel_launch: unexpected sizes n_in %d out %d ws %zu\n", n_in, out_size, ws_size);
    }
    if (grid < 0) return;
    Args a{};
    const float** pp = (const float**)&a;
    for (int i = 0; i < 23; ++i) pp[i] = (const float*)d_in[i];
    a.out = (float*)d_out; a.ws = (unsigned char*)d_ws;
#if MK_SPLIT
    for (int p = 0; p < 12; ++p) { a.ph_lo = p; a.ph_hi = p + 1; hipLaunchKernelGGL(mk_fwd, dim3(grid), dim3(NWAVES * 64), LDS_BYTES, stream, a); }
#else
    a.ph_lo = 0; a.ph_hi = 12;
    void* args[] = {&a};
    hipError_t e = hipLaunchCooperativeKernel((const void*)mk_fwd, dim3(grid), dim3(NWAVES * 64), args, LDS_BYTES, stream);
    if (e != hipSuccess) fprintf(stderr, "cooperative launch failed: %s (grid %d)\n", hipGetErrorString(e), grid);
#endif
}
```

```cpp
#include <hip/hip_runtime.h>
#include <hip/hip_cooperative_groups.h>
#include <cstdio>
#include <cstdint>
namespace cg = cooperative_groups;
namespace pg8 {
#define PG8_LAS __attribute__((address_space(3)))
typedef unsigned short bf16_t;
typedef short bf16x8 __attribute__((ext_vector_type(8)));
typedef float f32x4 __attribute__((ext_vector_type(4)));
typedef unsigned u32x4 __attribute__((ext_vector_type(4)));
constexpr int BM = 256, BK = 64, HALF = 128, HTB = HALF * BK * 2  , STAGE_BYTES = 8 * HTB, NXCD = 8, WGM = 8;

__host__ __device__ __forceinline__ int lds_byte(int r, int c) { const int st = (r >> 4) * 2 + (c >> 5), rr = r & 15, cc = c & 31, ob = rr * 64 + cc * 2; return st * 1024 + (ob ^ (((ob >> 9) & 1) << 5)); }
__host__ __device__ __forceinline__ void stage_rc(int b, int& R, int& C) { const int st = b / 1024, sb = b % 1024, swz = sb ^ (((sb >> 9) & 1) << 5); R = (st >> 1) * 16 + swz / 64; C = (st & 1) * 32 + (swz % 64) / 2; }
__host__ __device__ __forceinline__ int perm32(int rho) { const int n = rho >> 4, i = rho & 15; return 8 * (i >> 2) + 4 * n + (i & 3); }

struct Unit { int pm, pn; };
struct Gemm { const bf16_t* A; const bf16_t* Bt; int M, N, K; };

struct StaticOrder {
    int nM, nN, nwg, G, c;
    __host__ __device__ void init(int M, int N, int G_, int c_) { nM = M / BM; nN = N / BM; nwg = nM * nN; G = G_; c = c_; }
    __host__ __device__ bool next(int i, Unit& u) const {
        const long L = (long)i * G + c; if (L >= nwg) return false;
        int wgid = (int)L; { const int q = nwg / NXCD, r = nwg % NXCD, xcd = wgid % NXCD, off = wgid / NXCD; wgid = (xcd < r ? xcd * (q + 1) : r * (q + 1) + (xcd - r) * q) + off; }
        const int nig = WGM * nN, gid = wgid / nig, fm = gid * WGM, gsz = (nM - fm) < WGM ? (nM - fm) : WGM;
        u.pm = fm + ((wgid % nig) % gsz); u.pn = (wgid % nig) / gsz; return true;
    }
    __device__ __forceinline__ void a_ready(const Unit&) const {}
    __device__ __forceinline__ void done(const Unit&) const {}
};

__device__ __forceinline__ unsigned cvt_pk_bf16(float lo, float hi) { unsigned r; asm volatile("v_cvt_pk_bf16_f32 %0, %1, %2" : "=v"(r) : "v"(lo), "v"(hi)); return r; }
template <int ACT  > struct EpiB16 {
    static constexpr bool PERM = true, AFTER_DRAIN = false;
    bf16_t* O; int ldc;
    __device__ __forceinline__ void operator()(const f32x4 (&acc)[2][2][4][2], const Unit& u, int wr, int wc, int fr, int fq) const {
        const int row0 = u.pm * BM + wr * 64 + fr; const int col0 = u.pn * BM + wc * 32 + 8 * fq;
#pragma unroll
        for (int ai = 0; ai < 2; ++ai)
#pragma unroll
            for (int m = 0; m < 4; ++m) { bf16_t* rowp = O + (size_t)(row0 + ai * HALF + m * 16) * ldc + col0;
#pragma unroll
                for (int bj = 0; bj < 2; ++bj) { f32x4 v0 = acc[ai][bj][m][0], v1 = acc[ai][bj][m][1];
                    if (ACT == 1) {
#pragma unroll
                        for (int i = 0; i < 4; ++i) { float a = fmaxf(v0[i], 0.f), b = fmaxf(v1[i], 0.f); v0[i] = a * a; v1[i] = b * b; } }
                    u32x4 w; w.x = cvt_pk_bf16(v0[0], v0[1]); w.y = cvt_pk_bf16(v0[2], v0[3]); w.z = cvt_pk_bf16(v1[0], v1[1]); w.w = cvt_pk_bf16(v1[2], v1[3]);
                    *(u32x4*)(rowp + bj * HALF) = w; } }
    }
};
struct EpiF32 {
    static constexpr bool PERM = false, AFTER_DRAIN = false;
    float* O; int ldc;
    __device__ __forceinline__ void operator()(const f32x4 (&acc)[2][2][4][2], const Unit& u, int wr, int wc, int fr, int fq) const {
#pragma unroll
        for (int ai = 0; ai < 2; ++ai)
#pragma unroll
            for (int m = 0; m < 4; ++m) { float* rowp = O + (size_t)(u.pm * BM + ai * HALF + wr * 64 + m * 16 + fr) * ldc + u.pn * BM + wc * 32 + 4 * fq;
#pragma unroll
                for (int bj = 0; bj < 2; ++bj)
#pragma unroll
                    for (int n = 0; n < 2; ++n) *(f32x4*)(rowp + bj * HALF + n * 16) = acc[ai][bj][m][n]; }
    }
};
template <class Epi, class Sched, bool ALIGN_EPI = false, bool SP2 = false>
__device__ __forceinline__ void gemm_phase(PG8_LAS unsigned char* lds, const Gemm g, const Sched& S, const Epi& E) {
    const int tid = threadIdx.x, wid = __builtin_amdgcn_readfirstlane(tid >> 6), lane = tid & 63, wr = wid >> 2, wc = wid & 3, fr = lane & 15, fq = lane >> 4;
    const int K = g.K, nt = K / BK;
    unsigned voffA[2], voffB[2];
#pragma unroll
    for (int i = 0; i < 2; ++i) { int R, C; stage_rc(tid * 16 + i * 8192, R, C); const int Rb = Epi::PERM ? ((R & ~31) + perm32(R & 31)) : R;
        voffA[i] = (unsigned)(R * K + C) * 2u; voffB[i] = (unsigned)(Rb * K + C) * 2u; }
    const size_t kstep = (size_t)(BK * 2);
    const size_t hstep = (size_t)HALF * K * 2;
    const size_t tstep = 2 * hstep;
    const unsigned ldsw = (unsigned)wid * 1024u;
    const int aoff = lds_byte(wr * 64 + fr, fq * 8), boff = lds_byte(wc * 32 + fr, fq * 8);
#define PG8_SA(b, h) (((b) * 2 + (h)) * HTB)
#define PG8_SB(b, h) ((4 + (b) * 2 + (h)) * HTB)
#define PG8_STAGE(bufoff, gbase, voff) do { _Pragma("unroll") for (int _i = 0; _i < 2; ++_i) \
        __builtin_amdgcn_global_load_lds((const unsigned*)((const char*)(gbase) + (voff)[_i]), (PG8_LAS unsigned*)(lds + (bufoff) + ldsw + _i * 8192), 16, 0, 0); } while (0)
#define PG8_LDA(dst, b, h) do { _Pragma("unroll") for (int m = 0; m < 4; ++m) _Pragma("unroll") for (int k = 0; k < 2; ++k) dst[m][k] = *(const PG8_LAS bf16x8*)(lds + PG8_SA(b, h) + aoff + m * 2048 + k * 1024); } while (0)
#define PG8_LDB(dst, b, h) do { _Pragma("unroll") for (int n = 0; n < 2; ++n) _Pragma("unroll") for (int k = 0; k < 2; ++k) dst[n][k] = *(const PG8_LAS bf16x8*)(lds + PG8_SB(b, h) + boff + n * 2048 + k * 1024); } while (0)
#define PG8_MMA(ai, bj, At, Bt) do { __builtin_amdgcn_s_setprio(1); _Pragma("unroll") for (int m = 0; m < 4; ++m) _Pragma("unroll") for (int n = 0; n < 2; ++n) _Pragma("unroll") for (int k = 0; k < 2; ++k) \
        acc[ai][bj][m][n] = __builtin_amdgcn_mfma_f32_16x16x32_bf16(Bt[n][k], At[m][k], acc[ai][bj][m][n], 0, 0, 0); __builtin_amdgcn_s_setprio(0); } while (0)
#define PG8_WAIT_V(n) asm volatile("s_waitcnt vmcnt(" #n ")" ::: "memory")
#define PG8_WAIT_L(n) asm volatile("s_waitcnt lgkmcnt(" #n ")" ::: "memory")
#define PG8_BAR __builtin_amdgcn_s_barrier()
#define PG8_SCHED __builtin_amdgcn_sched_barrier(0)
    Unit cur, nxt; int ui = 0;
    if (!S.next(0, cur)) return;
    f32x4 acc[2][2][4][2];
#pragma unroll
    for (int a = 0; a < 2; ++a)
#pragma unroll
        for (int b = 0; b < 2; ++b)
#pragma unroll
            for (int m = 0; m < 4; ++m)
#pragma unroll
                for (int n = 0; n < 2; ++n) acc[a][b][m][n] = (f32x4){0.f, 0.f, 0.f, 0.f};
    bf16x8 At[4][2], B0[2][2], B1[2][2];
    const char* cA = (const char*)g.A + (size_t)cur.pm * tstep; const char* cB = (const char*)g.Bt + (size_t)cur.pn * tstep;
    S.a_ready(cur);
    if constexpr (SP2) {
        PG8_STAGE(PG8_SB(0, 0), cB, voffB); PG8_STAGE(PG8_SB(0, 1), cB + hstep, voffB); PG8_STAGE(PG8_SA(0, 0), cA, voffA); PG8_STAGE(PG8_SA(0, 1), cA + hstep, voffA);
        if (wr == 1) PG8_BAR;
        PG8_WAIT_V(2); PG8_BAR;
        PG8_STAGE(PG8_SB(1, 0), cB + kstep, voffB); PG8_STAGE(PG8_SA(1, 0), cA + kstep, voffA); PG8_STAGE(PG8_SB(1, 1), cB + hstep + kstep, voffB);
        PG8_WAIT_V(6); PG8_BAR;
    } else {
        PG8_STAGE(PG8_SB(0, 0), cB, voffB); PG8_STAGE(PG8_SA(0, 0), cA, voffA); PG8_STAGE(PG8_SB(0, 1), cB + hstep, voffB); PG8_STAGE(PG8_SA(0, 1), cA + hstep, voffA);
        if (wr == 1) PG8_BAR;
        PG8_WAIT_V(4); PG8_BAR;
        PG8_STAGE(PG8_SB(1, 0), cB + kstep, voffB); PG8_STAGE(PG8_SA(1, 0), cA + kstep, voffA); PG8_STAGE(PG8_SB(1, 1), cB + hstep + kstep, voffB);
        PG8_WAIT_V(6); PG8_BAR;
    }
    for (;;) {
        const bool has_next = S.next(ui + 1, nxt);
        const char* nA = has_next ? (const char*)g.A + (size_t)nxt.pm * tstep : cA; const char* nB = has_next ? (const char*)g.Bt + (size_t)nxt.pn * tstep : cB;
        for (int t = 0; t < nt; t += 2) {
            const bool last = (t == nt - 2);
            const char* a1 = cA + (size_t)(t + 1) * kstep;
            const char* a2 = last ? nA : cA + (size_t)(t + 2) * kstep; const char* b2 = last ? nB : cB + (size_t)(t + 2) * kstep;
            const char* a3 = a2 + kstep; const char* b3 = b2 + kstep;
            if (last && has_next) S.a_ready(nxt);
            if constexpr (SP2) {
            PG8_LDB(B0, 0, 0); PG8_LDB(B1, 0, 1); PG8_SCHED; PG8_LDA(At, 0, 0); PG8_STAGE(PG8_SA(1, 1), a1 + hstep, voffA);
            PG8_WAIT_V(8); PG8_WAIT_L(0); PG8_BAR; PG8_MMA(0, 0, At, B0); PG8_MMA(0, 1, At, B1); PG8_BAR; PG8_SCHED;
            PG8_LDA(At, 0, 1); PG8_STAGE(PG8_SB(0, 0), b2, voffB); PG8_STAGE(PG8_SB(0, 1), b2 + hstep, voffB); PG8_STAGE(PG8_SA(0, 0), a2, voffA);
            PG8_WAIT_V(8); PG8_WAIT_L(0); PG8_BAR; PG8_MMA(1, 0, At, B0); PG8_MMA(1, 1, At, B1); PG8_BAR; PG8_SCHED;
            PG8_LDB(B0, 1, 0); PG8_LDB(B1, 1, 1); PG8_SCHED; PG8_LDA(At, 1, 0); PG8_STAGE(PG8_SA(0, 1), a2 + hstep, voffA);
            PG8_WAIT_V(8); PG8_WAIT_L(0); PG8_BAR; PG8_MMA(0, 0, At, B0); PG8_MMA(0, 1, At, B1); PG8_BAR; PG8_SCHED;
            PG8_LDA(At, 1, 1); PG8_STAGE(PG8_SB(1, 0), b3, voffB); PG8_STAGE(PG8_SB(1, 1), b3 + hstep, voffB); PG8_STAGE(PG8_SA(1, 0), a3, voffA);
            PG8_WAIT_V(8); PG8_WAIT_L(0); PG8_BAR; PG8_MMA(1, 0, At, B0); PG8_MMA(1, 1, At, B1); PG8_BAR; PG8_SCHED;
            } else {
            PG8_LDB(B0, 0, 0); PG8_SCHED; PG8_LDA(At, 0, 0); PG8_STAGE(PG8_SA(1, 1), a1 + hstep, voffA);
            PG8_WAIT_L(8); PG8_BAR; PG8_WAIT_L(0); PG8_MMA(0, 0, At, B0); PG8_BAR; PG8_SCHED;
            PG8_LDB(B1, 0, 1); PG8_STAGE(PG8_SB(0, 0), b2, voffB);
            PG8_BAR; PG8_WAIT_L(0); PG8_MMA(0, 1, At, B1); PG8_BAR;
            PG8_LDA(At, 0, 1); PG8_STAGE(PG8_SA(0, 0), a2, voffA);
            PG8_BAR; PG8_WAIT_L(0); PG8_MMA(1, 0, At, B0); PG8_BAR; PG8_SCHED;
            PG8_STAGE(PG8_SB(0, 1), b2 + hstep, voffB);
            PG8_WAIT_V(6); PG8_BAR; PG8_MMA(1, 1, At, B1); PG8_BAR;
            PG8_LDB(B0, 1, 0); PG8_SCHED; PG8_LDA(At, 1, 0); PG8_STAGE(PG8_SA(0, 1), a2 + hstep, voffA);
            PG8_WAIT_L(8); PG8_BAR; PG8_WAIT_L(0); PG8_MMA(0, 0, At, B0); PG8_BAR; PG8_SCHED;
            PG8_LDB(B1, 1, 1); PG8_STAGE(PG8_SB(1, 0), b3, voffB);
            PG8_BAR; PG8_WAIT_L(0); PG8_MMA(0, 1, At, B1); PG8_BAR;
            PG8_LDA(At, 1, 1); PG8_STAGE(PG8_SA(1, 0), a3, voffA);
            PG8_BAR; PG8_WAIT_L(0); PG8_MMA(1, 0, At, B0); PG8_BAR; PG8_SCHED;
            PG8_STAGE(PG8_SB(1, 1), b3 + hstep, voffB);
            PG8_WAIT_V(6); PG8_BAR; PG8_MMA(1, 1, At, B1); PG8_BAR;
            }
        }
        if constexpr (ALIGN_EPI) { if (wr == 0) PG8_BAR; }
        if constexpr (!Epi::AFTER_DRAIN) { E(acc, cur, wr, wc, fr, fq); S.done(cur); }
        if (!has_next) break;
#pragma unroll
        for (int a = 0; a < 2; ++a)
#pragma unroll
            for (int b = 0; b < 2; ++b)
#pragma unroll
                for (int m = 0; m < 4; ++m)
#pragma unroll
                    for (int n = 0; n < 2; ++n) acc[a][b][m][n] = (f32x4){0.f, 0.f, 0.f, 0.f};
        cur = nxt; cA = nA; cB = nB; ++ui;
        if constexpr (ALIGN_EPI) { if (wr == 1) PG8_BAR; }
    }
    PG8_WAIT_V(0);
    if constexpr (!ALIGN_EPI) { if (wr == 0) PG8_BAR; }
    PG8_BAR;
    if constexpr (Epi::AFTER_DRAIN) { E.fused(acc, cur, wr, wc, fr, fq, lds, wid, lane); S.done(cur); }
#undef PG8_SA
#undef PG8_SB
#undef PG8_STAGE
#undef PG8_LDA
#undef PG8_LDB
#undef PG8_MMA
#undef PG8_WAIT_V
#undef PG8_WAIT_L
#undef PG8_BAR
#undef PG8_SCHED
}
}

constexpr int D = 1024, MP = 16384, MS = 128, MT = MP + MS, SEQ = 2048, NBATCH = 8, FF = 4096;
constexpr int NZ = 2560;
constexpr int INC = 2568;
constexpr int NMOD = 136, NMODP = 144, MODC = 6144;
constexpr int NCH = 32;
constexpr int NITEM = 1024;
constexpr float EPS = 1e-6f;
constexpr float KSCALE = 0.08838834764831845f;

constexpr size_t MiB = 1u << 20;
constexpr size_t WS_WIN = 2 * MiB, WS_WOUT = 7 * MiB, WS_WUP = 9 * MiB, WS_WDN = 17 * MiB, WS_WADA = 25 * MiB, WS_WPOOL = 37 * MiB;
constexpr size_t WS_SILU = 37 * MiB + 256 * 1024, WS_MOD = 38 * MiB, WS_GATES = 42 * MiB;
constexpr size_t WS_CHB = 43 * MiB, WS_CHM = WS_CHB + 4096, WS_MST = WS_CHM + 4096, WS_NU = 43 * MiB + 256 * 1024, WS_NST = 43 * MiB + 768 * 1024;
constexpr size_t WS_H = 45 * MiB;
constexpr size_t WS_Z = 78 * MiB;
constexpr size_t WS_U = 159 * MiB;
constexpr size_t WS_CST = 223 * MiB;
constexpr size_t WS_T1 = 78 * MiB;
constexpr size_t WS_F = 78 * MiB;
constexpr size_t WS_T2 = 208 * MiB;
static_assert(WS_NST + 512 * 1024 <= WS_H && WS_H + (size_t)MT * D * 2 <= WS_Z && WS_Z + (size_t)MT * NZ * 2 <= WS_U && WS_CST + 32 * MiB <= 256 * MiB, "ws map");
static_assert(WS_F + (size_t)MT * FF * 2 <= WS_T2 && WS_T2 + (size_t)MT * D * 2 <= 256 * MiB && WS_T1 + (size_t)MT * D * 4 <= WS_U, "ws map 2");

constexpr size_t O_YP = 0, O_YS = 16777216, O_CP = 16908288, O_NP = 17432576, O_MP = 17436672, O_PP = 17436704, O_CS = 17498144, O_NS = 25886752, O_MS = 25952288, O_PS = 25952800, O_END = 26935840;

constexpr int LDS_BYTES = 147456;
constexpr int CW_BAR = 4096;
constexpr size_t CTL_ZERO_BYTES = 65536;
constexpr int NWAVES = 8;

typedef unsigned short bf16;
typedef unsigned u32x4 __attribute__((ext_vector_type(4)));
typedef unsigned u32x2 __attribute__((ext_vector_type(2)));
typedef float f32x4 __attribute__((ext_vector_type(4)));
typedef short bf16x8 __attribute__((ext_vector_type(8)));

struct Args {
    const float *x_prompt, *x_sample, *c_prompt, *c_sample, *state_C, *state_n, *state_m, *state_pool, *w_ada, *b_ada, *g_pre1, *g_post1, *w_in, *b_ig, *b_fg, *g_head, *w_pool,
        *pool_scale, *w_out, *g_pre2, *g_post2, *w_up, *w_down;
    float* out; unsigned char* ws;
    int ph_lo, ph_hi;
};

__device__ __forceinline__ unsigned f2bf(float f) { unsigned u = __builtin_bit_cast(unsigned, f); return (u + 0x7fffu + ((u >> 16) & 1u)) >> 16; }
__device__ __forceinline__ unsigned pk2(float lo, float hi) { return f2bf(lo) | (f2bf(hi) << 16); }
__device__ __forceinline__ float bf2f(unsigned h) { return __builtin_bit_cast(float, h << 16); }
__device__ __forceinline__ float bflo(unsigned w) { return __builtin_bit_cast(float, w << 16); }
__device__ __forceinline__ float bfhi(unsigned w) { return __builtin_bit_cast(float, w & 0xffff0000u); }
__device__ __forceinline__ float wave_sum(float v) {
#pragma unroll
    for (int o = 1; o < 64; o <<= 1) v += __shfl_xor(v, o);
    return v;
}
__device__ __forceinline__ float wave_max(float v) {
#pragma unroll
    for (int o = 1; o < 64; o <<= 1) v = fmaxf(v, __shfl_xor(v, o));
    return v;
}
__device__ __forceinline__ float sigmoidf_(float x) { return 1.f / (1.f + __expf(-x)); }
__device__ __forceinline__ int mod_row(int row) { return row < MP ? (row >> 11) : (NBATCH + row - MP); }
__device__ __forceinline__ f32x4 mfma16(bf16x8 a, bf16x8 b, f32x4 c) { return __builtin_amdgcn_mfma_f32_16x16x32_bf16(a, b, c, 0, 0, 0); }

__device__ __forceinline__ void transpose_item(const float* W, int ldw, int nblk, int K, bf16* WT, float* scr, int item, int lane, float scale) {
    const int kb = item / nblk, nb = item % nblk, k0 = 64 * kb, n0 = 32 * nb;
#pragma unroll 8
    for (int i = 0; i < 32; ++i) { const int kk = 2 * i + (lane >> 5); scr[kk * 33 + (lane & 31)] = W[(size_t)(k0 + kk) * ldw + n0 + (lane & 31)] * scale; }
    asm volatile("s_waitcnt lgkmcnt(0)" ::: "memory");
    const int c = lane & 7;
#pragma unroll
    for (int j = 0; j < 4; ++j) { const int n = (lane >> 3) + 8 * j; const float* s = scr + (8 * c) * 33 + n;
        u32x4 o; o.x = pk2(s[0 * 33], s[1 * 33]); o.y = pk2(s[2 * 33], s[3 * 33]); o.z = pk2(s[4 * 33], s[5 * 33]); o.w = pk2(s[6 * 33], s[7 * 33]);
        *(u32x4*)(WT + (size_t)(n0 + n) * K + k0 + 8 * c) = o; }
    asm volatile("s_waitcnt lgkmcnt(0)" ::: "memory");
}

__device__ __forceinline__ void phase0(const Args& a, unsigned char* lds, int gw, int NGW, int lane, int wave) {
    float* scr = (float*)(lds + wave * 16384);
    unsigned char* ws = a.ws;
    constexpr int I_INA = 16 * 64, I_INB = 16 * 16, I_OUT = 16 * 32, I_UP = 16 * 128, I_DN = 64 * 32, I_ADA = 16 * 192, I_POOL = 32;
    constexpr int NIT = I_INA + I_INB + I_OUT + I_UP + I_DN + I_ADA + I_POOL;
    for (int it = gw; it < NIT; it += NGW) {
        int r = it;
        if (r < I_INA) { const int nb = r % 64; const float sc = (nb >= 16 && nb < 32) ? KSCALE : 1.f; transpose_item(a.w_in, INC, 64, D, (bf16*)(ws + WS_WIN), scr, r, lane, sc); continue; } r -= I_INA;
        if (r < I_INB) { transpose_item(a.w_in + 2056, INC, 16, D, (bf16*)(ws + WS_WIN) + (size_t)2048 * D, scr, r, lane, 1.f); continue; } r -= I_INB;
        if (r < I_OUT) { transpose_item(a.w_out, D, 32, D, (bf16*)(ws + WS_WOUT), scr, r, lane, 1.f); continue; } r -= I_OUT;
        if (r < I_UP) { transpose_item(a.w_up, FF, 128, D, (bf16*)(ws + WS_WUP), scr, r, lane, 1.f); continue; } r -= I_UP;
        if (r < I_DN) { transpose_item(a.w_down, D, 32, FF, (bf16*)(ws + WS_WDN), scr, r, lane, 1.f); continue; } r -= I_DN;
        if (r < I_ADA) { transpose_item(a.w_ada, MODC, 192, D, (bf16*)(ws + WS_WADA), scr, r, lane, 1.f); continue; } r -= I_ADA;
        { const int g = r >> 3; transpose_item(a.w_pool + g * 16384, 128, 4, 128, (bf16*)(ws + WS_WPOOL) + g * 16384, scr, r & 7, lane, 1.f); }
    }
    bf16* S = (bf16*)(ws + WS_SILU);
    for (int i = gw * 64 + lane; i < NMODP * D; i += NGW * 64) {
        const int row = i >> 10, col = i & 1023; float v = 0.f;
        if (row < NBATCH) v = a.c_prompt[row * D + col]; else if (row < NMOD) v = a.c_sample[(row - NBATCH) * D + col];
        S[i] = (bf16)f2bf(v * sigmoidf_(v));
    }
}

template <int MODE> __device__ __forceinline__ void small_gemm(const bf16* A, const bf16* Bt, int N, int K, int Mtiles, int gw, int NGW, int lane, void* outp, const float* bias) {
    const int fr = lane & 15, fq = lane >> 4;
    const int ntile = Mtiles * (N >> 4);
    for (int tile = gw; tile < ntile; tile += NGW) {
        const int mt = tile % Mtiles, nt = tile / Mtiles;
        const bf16* ap = A + (size_t)(mt * 16 + fr) * K + fq * 8;
        const bf16* bp = Bt + (size_t)(nt * 16 + fr) * K + fq * 8;
        f32x4 acc = (f32x4){0.f, 0.f, 0.f, 0.f};
#pragma unroll 8
        for (int k = 0; k < K; k += 32) { const bf16x8 av = *(const bf16x8*)(ap + k); const bf16x8 bv = *(const bf16x8*)(bp + k); acc = mfma16(av, bv, acc); }
        const int col = nt * 16 + fr;
#pragma unroll
        for (int j = 0; j < 4; ++j) { const int row = mt * 16 + fq * 4 + j; const float v = acc[j];
            if (MODE == 0) { if (row < NMOD) ((float*)outp)[(size_t)row * MODC + col] = v + bias[col]; }
            else if (MODE == 1) ((bf16*)outp)[(size_t)row * NZ + col] = (bf16)f2bf(v);
            else if (MODE == 2) ((float*)outp)[(size_t)row * D + col] = v;
            else if (MODE == 3) { const float r = fmaxf(v, 0.f); ((bf16*)outp)[(size_t)row * FF + col] = (bf16)f2bf(r * r); }
            else ((bf16*)outp)[(size_t)row * D + col] = (bf16)f2bf(v); }
    }
}

__device__ __forceinline__ void phase1a(const Args& a, unsigned char* lds, int gw, int NGW, int lane, int tid) {
    f32x4* wg4 = (f32x4*)lds;
    for (int i = tid; i < 2048; i += 512) { const int k = i >> 1, hf = i & 1; wg4[i] = *(const f32x4*)(a.w_in + (size_t)k * INC + 2048 + hf * 4); }
    __syncthreads();
    const float* MOD = (const float*)(a.ws + WS_MOD); bf16* HN = (bf16*)(a.ws + WS_H); float* GATES = (float*)(a.ws + WS_GATES);
    for (int row = gw; row < MT; row += NGW) {
        const float* xr = row < MP ? a.x_prompt + (size_t)row * D : a.x_sample + (size_t)(row - MP) * D;
        const float* md = MOD + (size_t)mod_row(row) * MODC;
        f32x4 v[4]; float ss = 0.f;
#pragma unroll
        for (int j = 0; j < 4; ++j) { v[j] = *(const f32x4*)(xr + j * 256 + lane * 4); ss += (v[j][0] * v[j][0] + v[j][1] * v[j][1]) + (v[j][2] * v[j][2] + v[j][3] * v[j][3]); }
        const float rstd = rsqrtf(wave_sum(ss) * (1.f / D) + EPS);
        float g0 = 0.f, g1 = 0.f, g2 = 0.f, g3 = 0.f, g4 = 0.f, g5 = 0.f, g6 = 0.f, g7 = 0.f;
#pragma unroll
        for (int j = 0; j < 4; ++j) { const int col = j * 256 + lane * 4;
            const f32x4 gp = *(const f32x4*)(a.g_pre1 + col), sh = *(const f32x4*)(md + col), sc = *(const f32x4*)(md + D + col);
            f32x4 h = v[j] * rstd * gp * (sc + 1.f) + sh;
            u32x2 o; o.x = pk2(h[0], h[1]); o.y = pk2(h[2], h[3]); *(u32x2*)(HN + (size_t)row * D + col) = o;
#pragma unroll
            for (int i = 0; i < 4; ++i) { const f32x4 w0 = wg4[(col + i) * 2], w1 = wg4[(col + i) * 2 + 1]; const float hv = h[i];
                g0 += hv * w0[0]; g1 += hv * w0[1]; g2 += hv * w0[2]; g3 += hv * w0[3]; g4 += hv * w1[0]; g5 += hv * w1[1]; g6 += hv * w1[2]; g7 += hv * w1[3]; } }
        g0 = wave_sum(g0); g1 = wave_sum(g1); g2 = wave_sum(g2); g3 = wave_sum(g3); g4 = wave_sum(g4); g5 = wave_sum(g5); g6 = wave_sum(g6); g7 = wave_sum(g7);
        if (lane == 0) {
            f32x4 ig = (f32x4){g0 + a.b_ig[0], g1 + a.b_ig[1], g2 + a.b_ig[2], g3 + a.b_ig[3]};
            f32x4 fg = (f32x4){g4 + a.b_fg[0], g5 + a.b_fg[1], g6 + a.b_fg[2], g7 + a.b_fg[3]}; f32x4 lf;
#pragma unroll
            for (int i = 0; i < 4; ++i) lf[i] = fminf(fg[i], 0.f) - log1pf(expf(-fabsf(fg[i])));
            *(f32x4*)(GATES + (size_t)row * 8) = ig; *(f32x4*)(GATES + (size_t)row * 8 + 4) = lf;
        }
    }
    __syncthreads();
}

__device__ __forceinline__ void p2_chunk_item(const Args& a, unsigned char* lds, int it, int tid, int lane, int wave) {
    const int bh = it >> 5, c = it & 31, b = bh >> 2, h = bh & 3, r0 = b * SEQ + c * 64;
    const bf16* Z = (const bf16*)(a.ws + WS_Z); const float* GATES = (const float*)(a.ws + WS_GATES);
    float* wLs = (float*)lds; bf16* KT = (bf16*)(lds + 1024); bf16* VT = (bf16*)(lds + 1024 + 18432);
    if (wave == 0) {
        const float lf = GATES[(size_t)(r0 + lane) * 8 + 4 + h], ig = GATES[(size_t)(r0 + lane) * 8 + h];
        float bs = lf;
#pragma unroll
        for (int o = 1; o < 64; o <<= 1) { const float t = __shfl_up(bs, o); if (lane >= o) bs += t; }
        const float B = __shfl(bs, 63); const float val = B - bs + ig; const float mloc = wave_max(val);
        wLs[lane] = __expf(val - mloc);
        if (lane == 0) { ((float*)(a.ws + WS_CHB))[it] = B; ((float*)(a.ws + WS_CHM))[it] = mloc; }
    }
    __syncthreads();
#pragma unroll
    for (int rep = 0; rep < 2; ++rep) { const int idx = tid + rep * 512, s = idx >> 4, dv = idx & 15;
        const u32x4 kv = *(const u32x4*)(Z + (size_t)(r0 + s) * NZ + 512 + h * 128 + dv * 8); const u32x4 vv = *(const u32x4*)(Z + (size_t)(r0 + s) * NZ + 1024 + h * 128 + dv * 8);
        const float w = wLs[s];
#pragma unroll
        for (int j = 0; j < 4; ++j) { KT[(dv * 8 + 2 * j) * 72 + s] = (bf16)f2bf(bflo(kv[j]) * w); KT[(dv * 8 + 2 * j + 1) * 72 + s] = (bf16)f2bf(bfhi(kv[j]) * w);
            VT[(dv * 8 + 2 * j) * 72 + s] = (bf16)(vv[j] & 0xffffu); VT[(dv * 8 + 2 * j + 1) * 72 + s] = (bf16)(vv[j] >> 16); } }
    __syncthreads();
    const int fr = lane & 15, fq = lane >> 4;
    float* U = (float*)(a.ws + WS_U) + (size_t)it * 16384;
    const bf16x8 a0 = *(const bf16x8*)(VT + (wave * 16 + fr) * 72 + fq * 8), a1 = *(const bf16x8*)(VT + (wave * 16 + fr) * 72 + 32 + fq * 8);
#pragma unroll
    for (int dt = 0; dt < 8; ++dt) { const bf16x8 b0 = *(const bf16x8*)(KT + (dt * 16 + fr) * 72 + fq * 8), b1 = *(const bf16x8*)(KT + (dt * 16 + fr) * 72 + 32 + fq * 8);
        f32x4 acc = mfma16(a0, b0, (f32x4){0.f, 0.f, 0.f, 0.f}); acc = mfma16(a1, b1, acc);
#pragma unroll
        for (int j = 0; j < 4; ++j) U[(wave * 16 + fq * 4 + j) * 128 + dt * 16 + fr] = acc[j]; }
    if (tid < 128) { float s = 0.f;
        for (int i = 0; i < 64; ++i) s += bf2f(KT[tid * 72 + i]);
        ((float*)(a.ws + WS_NU))[(size_t)it * 128 + tid] = s; }
    __syncthreads();
}

__device__ __forceinline__ void pool_mma(const Args& a, const bf16* Ps, int gi, int rowbase, int lane, int wave) {
    const int fr = lane & 15, fq = lane >> 4, tt = wave & 3, dh = wave >> 2;
    const bf16* WP = (const bf16*)(a.ws + WS_WPOOL) + gi * 16384; bf16* MIX = (bf16*)(a.ws + WS_H);
    bf16x8 pa[4];
#pragma unroll
    for (int ks = 0; ks < 4; ++ks) pa[ks] = *(const bf16x8*)(Ps + (tt * 16 + fr) * 136 + ks * 32 + fq * 8);
#pragma unroll
    for (int i = 0; i < 4; ++i) { const int dt = dh * 4 + i; f32x4 acc = (f32x4){0.f, 0.f, 0.f, 0.f};
#pragma unroll
        for (int ks = 0; ks < 4; ++ks) { const bf16x8 wb = *(const bf16x8*)(WP + (dt * 16 + fr) * 128 + ks * 32 + fq * 8); acc = mfma16(pa[ks], wb, acc); }
        const int dcol = dt * 16 + fr; const float sc = a.pool_scale[gi * 128 + dcol];
#pragma unroll
        for (int j = 0; j < 4; ++j) MIX[(size_t)(rowbase + tt * 16 + fq * 4 + j) * D + 512 + gi * 128 + dcol] = (bf16)f2bf(acc[j] * sc); }
}

__device__ __forceinline__ void p2_pool_prompt_item(const Args& a, unsigned char* lds, int itp, int tid, int lane, int wave) {
    const int b = itp >> 5, tile = itp & 31, t0 = tile * 64, r0 = b * SEQ + t0;
    const bf16* Z = (const bf16*)(a.ws + WS_Z);
    bf16* Us = (bf16*)lds; bf16* Ps = (bf16*)(lds + 20480);
    for (int gi = 0; gi < 4; ++gi) {
        for (int idx = tid; idx < 79 * 16; idx += 512) { const int i = idx >> 4, cv = idx & 15, t = t0 - 15 + i;
            u32x4 val = (u32x4){0u, 0u, 0u, 0u};
            if (t >= 0) val = *(const u32x4*)(Z + (size_t)(b * SEQ + t) * NZ + 2048 + gi * 128 + cv * 8);
            *(u32x4*)(Us + i * 128 + cv * 8) = val; }
        __syncthreads();
        const int win = 2 << gi;
#pragma unroll
        for (int rep = 0; rep < 2; ++rep) { const int idx = tid + rep * 512, tl = idx >> 4, cv = idx & 15, t = t0 + tl;
            const float inv = 1.f / (float)min(t + 1, win);
            float s0 = 0.f, s1 = 0.f, s2 = 0.f, s3 = 0.f, s4 = 0.f, s5 = 0.f, s6 = 0.f, s7 = 0.f;
            for (int jj = 0; jj < win; ++jj) { const u32x4 w = *(const u32x4*)(Us + (tl + 15 - jj) * 128 + cv * 8);
                s0 += bflo(w[0]); s1 += bfhi(w[0]); s2 += bflo(w[1]); s3 += bfhi(w[1]); s4 += bflo(w[2]); s5 += bfhi(w[2]); s6 += bflo(w[3]); s7 += bfhi(w[3]); }
            const u32x4 uu = *(const u32x4*)(Us + (tl + 15) * 128 + cv * 8);
            u32x4 o; o.x = pk2(s0 * inv - bflo(uu[0]), s1 * inv - bfhi(uu[0])); o.y = pk2(s2 * inv - bflo(uu[1]), s3 * inv - bfhi(uu[1]));
            o.z = pk2(s4 * inv - bflo(uu[2]), s5 * inv - bfhi(uu[2])); o.w = pk2(s6 * inv - bflo(uu[3]), s7 * inv - bfhi(uu[3]));
            *(u32x4*)(Ps + tl * 136 + cv * 8) = o; }
        __syncthreads();
        pool_mma(a, Ps, gi, r0, lane, wave);
        if (tile == 31) { float* PP = a.out + O_PP;
            for (int idx = tid; idx < 15 * 128; idx += 512) { const int i = idx >> 7, cc = idx & 127; PP[(size_t)(b * 15 + i) * 512 + gi * 128 + cc] = bf2f(Us[(64 + i) * 128 + cc]); } }
        __syncthreads();
    }
}

__device__ __forceinline__ void p2_pool_sample_item(const Args& a, unsigned char* lds, int tile, int tid, int lane, int wave) {
    const bf16* Z = (const bf16*)(a.ws + WS_Z);
    bf16* Ps = (bf16*)(lds + 20480);
    for (int gi = 0; gi < 4; ++gi) {
        const int win = 2 << gi; const float inv = 1.f / (float)win;
#pragma unroll
        for (int rep = 0; rep < 2; ++rep) { const int idx = tid + rep * 512, tl = idx >> 4, cv = idx & 15, bsi = tile * 64 + tl;
            const u32x4 uu = *(const u32x4*)(Z + (size_t)(MP + bsi) * NZ + 2048 + gi * 128 + cv * 8);
            float s0 = bflo(uu[0]), s1 = bfhi(uu[0]), s2 = bflo(uu[1]), s3 = bfhi(uu[1]), s4 = bflo(uu[2]), s5 = bfhi(uu[2]), s6 = bflo(uu[3]), s7 = bfhi(uu[3]);
            for (int jj = 1; jj < win; ++jj) { const float* sp = a.state_pool + (size_t)(bsi * 15 + 15 - jj) * 512 + gi * 128 + cv * 8;
                const f32x4 p0 = *(const f32x4*)sp, p1 = *(const f32x4*)(sp + 4);
                s0 += p0[0]; s1 += p0[1]; s2 += p0[2]; s3 += p0[3]; s4 += p1[0]; s5 += p1[1]; s6 += p1[2]; s7 += p1[3]; }
            u32x4 o; o.x = pk2(s0 * inv - bflo(uu[0]), s1 * inv - bfhi(uu[0])); o.y = pk2(s2 * inv - bflo(uu[1]), s3 * inv - bfhi(uu[1]));
            o.z = pk2(s4 * inv - bflo(uu[2]), s5 * inv - bfhi(uu[2])); o.w = pk2(s6 * inv - bflo(uu[3]), s7 * inv - bfhi(uu[3]));
            *(u32x4*)(Ps + tl * 136 + cv * 8) = o; }
        __syncthreads();
        pool_mma(a, Ps, gi, MP + tile * 64, lane, wave);
        __syncthreads();
    }
}

__device__ __forceinline__ void p2_sample_item(const Args& a, unsigned char* lds, int it2, int tid, int lane, int wave) {
    const int bs = it2 >> 2, h = it2 & 3, r = MP + bs, sh = bs * 4 + h;
    const bf16* Z = (const bf16*)(a.ws + WS_Z); const float* GATES = (const float*)(a.ws + WS_GATES); bf16* MIX = (bf16*)(a.ws + WS_H);
    float* qs = (float*)lds; float* ks = qs + 128; float* vs = qs + 256; float* scal = qs + 384; float* hs = qs + 512; float* red = qs + 1024;
    if (tid < 128) { qs[tid] = bf2f(Z[(size_t)r * NZ + h * 128 + tid]); ks[tid] = bf2f(Z[(size_t)r * NZ + 512 + h * 128 + tid]); vs[tid] = bf2f(Z[(size_t)r * NZ + 1024 + h * 128 + tid]); }
    __syncthreads();
    if (wave == 0) {
        const float n0a = a.state_n[(size_t)sh * 128 + lane], n0b = a.state_n[(size_t)sh * 128 + 64 + lane];
        const float qk = wave_sum(qs[lane] * ks[lane] + qs[lane + 64] * ks[lane + 64]);
        const float qn = wave_sum(qs[lane] * n0a + qs[lane + 64] * n0b);
        const float ig = GATES[(size_t)r * 8 + h], lf = GATES[(size_t)r * 8 + 4 + h], m0 = a.state_m[sh];
        const float g = lf + m0, m = fmaxf(g, ig), w = __expf(ig - m), al = __expf(g - m);
        const float s = qk * w, den = al * qn + s, dn = fmaxf(fabsf(den), __expf(-m));
        if (lane == 0) { scal[0] = al; scal[1] = w; scal[2] = s; scal[3] = dn; a.out[O_MS + sh] = m; }
        a.out[O_NS + (size_t)sh * 128 + lane] = al * n0a + w * ks[lane]; a.out[O_NS + (size_t)sh * 128 + 64 + lane] = al * n0b + w * ks[lane + 64];
    }
    __syncthreads();
    {
        const int e4 = (tid & 31) * 4, dg = tid >> 5; const float al = scal[0], w = scal[1];
        const f32x4 v4 = *(const f32x4*)(vs + e4); f32x4 part = (f32x4){0.f, 0.f, 0.f, 0.f};
        const float* C0 = a.state_C + (size_t)sh * 16384; float* C1 = a.out + O_CS + (size_t)sh * 16384;
#pragma unroll
        for (int dd = 0; dd < 8; ++dd) { const int d = dg * 8 + dd; const f32x4 c0 = *(const f32x4*)(C0 + d * 128 + e4);
            part += c0 * qs[d]; *(f32x4*)(C1 + d * 128 + e4) = c0 * al + v4 * (w * ks[d]); }
        *(f32x4*)(red + dg * 128 + e4) = part;
    }
    __syncthreads();
    if (tid < 128) { float qc = 0.f;
#pragma unroll
        for (int dg = 0; dg < 16; ++dg) qc += red[dg * 128 + tid];
        hs[tid] = (scal[0] * qc + scal[2] * vs[tid]) / scal[3]; }
    __syncthreads();
    if (wave == 0) {
        const float h0 = hs[lane], h1 = hs[lane + 64];
        const float rstd = rsqrtf(wave_sum(h0 * h0 + h1 * h1) * (1.f / 128.f) + EPS);
        const float o0 = bf2f(Z[(size_t)r * NZ + 1536 + h * 128 + lane]), o1 = bf2f(Z[(size_t)r * NZ + 1536 + h * 128 + 64 + lane]);
        MIX[(size_t)r * D + h * 128 + lane] = (bf16)f2bf(h0 * rstd * a.g_head[lane] * sigmoidf_(o0));
        MIX[(size_t)r * D + h * 128 + 64 + lane] = (bf16)f2bf(h1 * rstd * a.g_head[lane + 64] * sigmoidf_(o1));
    }
    for (int idx = tid; idx < 15 * 128; idx += 512) { const int i = idx >> 7, cc = h * 128 + (idx & 127);
        a.out[O_PS + (size_t)(bs * 15 + i) * 512 + cc] = i < 14 ? a.state_pool[(size_t)(bs * 15 + i + 1) * 512 + cc] : bf2f(Z[(size_t)r * NZ + 2048 + cc]); }
    __syncthreads();
}

__device__ __forceinline__ void phase2(const Args& a, unsigned char* lds, int tid, int lane, int wave) {
    constexpr int N1 = NITEM, N2 = N1 + 256, N3 = N2 + 2, N4 = N3 + 512;
    for (int it = blockIdx.x; it < N4; it += gridDim.x) {
        if (it < N1) p2_chunk_item(a, lds, it, tid, lane, wave);
        else if (it < N2) p2_pool_prompt_item(a, lds, it - N1, tid, lane, wave);
        else if (it < N3) p2_pool_sample_item(a, lds, it - N2, tid, lane, wave);
        else p2_sample_item(a, lds, it - N3, tid, lane, wave);
    }
}

__device__ __forceinline__ void phase3(const Args& a, int tid) {
    const float* U = (const float*)(a.ws + WS_U); bf16* CST = (bf16*)(a.ws + WS_CST);
    const float* CHB = (const float*)(a.ws + WS_CHB); const float* CHM = (const float*)(a.ws + WS_CHM); float* MST = (float*)(a.ws + WS_MST);
    const float* NU = (const float*)(a.ws + WS_NU); float* NST = (float*)(a.ws + WS_NST);
    for (int idx = blockIdx.x * 512 + tid; idx < 32 * 4096; idx += gridDim.x * 512) {
        const int bh = idx >> 12, rem = idx & 4095, e = rem >> 5, d4 = (rem & 31) * 4;
        f32x4 C = (f32x4){0.f, 0.f, 0.f, 0.f}; float m = 0.f, nacc = 0.f;
#pragma unroll 4
        for (int c = 0; c < NCH; ++c) { const int it = bh * 32 + c;
            const f32x4 u = *(const f32x4*)(U + (size_t)it * 16384 + e * 128 + d4);
            u32x2 o; o.x = pk2(C[0], C[1]); o.y = pk2(C[2], C[3]); *(u32x2*)(CST + (size_t)it * 16384 + e * 128 + d4) = o;
            float nu = 0.f;
            if (rem < 128) { NST[(size_t)it * 128 + rem] = nacc; nu = NU[(size_t)it * 128 + rem]; }
            if (rem == 0) MST[it] = m;
            const float B = CHB[it], ml = CHM[it], m2 = fmaxf(B + m, ml), al = __expf(B + m - m2), be = __expf(ml - m2);
            C = C * al + u * be; nacc = al * nacc + be * nu; m = m2; }
        float* CP = a.out + O_CP + (size_t)bh * 16384;
#pragma unroll
        for (int i = 0; i < 4; ++i) CP[(d4 + i) * 128 + e] = C[i];
        if (rem < 128) a.out[O_NP + (size_t)bh * 128 + rem] = nacc;
        if (rem == 0) a.out[O_MP + bh] = m;
    }
}

__device__ __forceinline__ void p4_item(const Args& a, unsigned char* lds, int it, int tid, int lane, int wave) {
    const int bh = it >> 5, c = it & 31, b = bh >> 2, h = bh & 3, r0 = b * SEQ + c * 64;
    const bf16* Z = (const bf16*)(a.ws + WS_Z); const float* GATES = (const float*)(a.ws + WS_GATES); bf16* MIX = (bf16*)(a.ws + WS_H);
    const bf16* CST = (const bf16*)(a.ws + WS_CST) + (size_t)it * 16384;
    float* bsA = (float*)lds; float* csA = bsA + 64; float* msA = bsA + 128; float* aA = bsA + 192; float* dnA = bsA + 256; float* n0s = bsA + 320;
    bf16* VT = (bf16*)(lds + 2048); bf16* Ss = (bf16*)(lds + 20480); float* Hs = (float*)(lds + 29696);
    const int fr = lane & 15, fq = lane >> 4, tt = wave & 3, eh = wave >> 2;
    if (wave == 0) {
        const float lf = GATES[(size_t)(r0 + lane) * 8 + 4 + h], ig = GATES[(size_t)(r0 + lane) * 8 + h];
        float bs = lf;
#pragma unroll
        for (int o = 1; o < 64; o <<= 1) { const float t = __shfl_up(bs, o); if (lane >= o) bs += t; }
        const float cs = ig - bs; float pm = cs;
#pragma unroll
        for (int o = 1; o < 64; o <<= 1) { const float t = __shfl_up(pm, o); if (lane >= o) pm = fmaxf(pm, t); }
        const float m0 = ((const float*)(a.ws + WS_MST))[it];
        const float mt = bs + fmaxf(m0, pm);
        bsA[lane] = bs; csA[lane] = cs; msA[lane] = mt; aA[lane] = __expf(bs + m0 - mt);
    }
    if (tid >= 128 && tid < 256) n0s[tid - 128] = ((const float*)(a.ws + WS_NST))[(size_t)it * 128 + tid - 128];
#pragma unroll
    for (int rep = 0; rep < 2; ++rep) { const int idx = tid + rep * 512, s = idx >> 4, dv = idx & 15;
        const u32x4 vv = *(const u32x4*)(Z + (size_t)(r0 + s) * NZ + 1024 + h * 128 + dv * 8);
#pragma unroll
        for (int j = 0; j < 4; ++j) { VT[(dv * 8 + 2 * j) * 72 + s] = (bf16)(vv[j] & 0xffffu); VT[(dv * 8 + 2 * j + 1) * 72 + s] = (bf16)(vv[j] >> 16); } }
    bf16x8 qa[4];
#pragma unroll
    for (int ks = 0; ks < 4; ++ks) qa[ks] = *(const bf16x8*)(Z + (size_t)(r0 + tt * 16 + fr) * NZ + h * 128 + ks * 32 + fq * 8);
    __syncthreads();
#pragma unroll
    for (int si = 0; si < 2; ++si) { const int st = eh * 2 + si; f32x4 acc = (f32x4){0.f, 0.f, 0.f, 0.f};
#pragma unroll
        for (int ks = 0; ks < 4; ++ks) { const bf16x8 kb = *(const bf16x8*)(Z + (size_t)(r0 + st * 16 + fr) * NZ + 512 + h * 128 + ks * 32 + fq * 8); acc = mfma16(qa[ks], kb, acc); }
        const int sidx = st * 16 + fr; const float cs = csA[sidx];
#pragma unroll
        for (int j = 0; j < 4; ++j) { const int t = tt * 16 + fq * 4 + j; const float wgt = (sidx <= t) ? __expf(bsA[t] + cs - msA[t]) : 0.f;
            Ss[t * 72 + sidx] = (bf16)f2bf(acc[j] * wgt); } }
    __syncthreads();
    { const int t = tid >> 3, sub = tid & 7;
        const u32x4 q0 = *(const u32x4*)(Z + (size_t)(r0 + t) * NZ + h * 128 + sub * 16), q1 = *(const u32x4*)(Z + (size_t)(r0 + t) * NZ + h * 128 + sub * 16 + 8);
        const float* nn = n0s + sub * 16; float qn = 0.f;
#pragma unroll
        for (int j = 0; j < 4; ++j) { qn += bflo(q0[j]) * nn[2 * j] + bfhi(q0[j]) * nn[2 * j + 1]; qn += bflo(q1[j]) * nn[8 + 2 * j] + bfhi(q1[j]) * nn[8 + 2 * j + 1]; }
        const u32x4 sv = *(const u32x4*)(Ss + t * 72 + sub * 8); float ssum = 0.f;
#pragma unroll
        for (int j = 0; j < 4; ++j) ssum += bflo(sv[j]) + bfhi(sv[j]);
        qn += __shfl_xor(qn, 1); qn += __shfl_xor(qn, 2); qn += __shfl_xor(qn, 4);
        ssum += __shfl_xor(ssum, 1); ssum += __shfl_xor(ssum, 2); ssum += __shfl_xor(ssum, 4);
        if (sub == 0) dnA[t] = fmaxf(fabsf(aA[t] * qn + ssum), __expf(-msA[t])); }
    f32x4 num[4];
#pragma unroll
    for (int i = 0; i < 4; ++i) { const int et = eh * 4 + i; f32x4 acc1 = (f32x4){0.f, 0.f, 0.f, 0.f}, acc2 = (f32x4){0.f, 0.f, 0.f, 0.f};
#pragma unroll
        for (int ks = 0; ks < 4; ++ks) { const bf16x8 cb = *(const bf16x8*)(CST + (et * 16 + fr) * 128 + ks * 32 + fq * 8); acc1 = mfma16(qa[ks], cb, acc1); }
#pragma unroll
        for (int ks = 0; ks < 2; ++ks) { const bf16x8 sa = *(const bf16x8*)(Ss + (tt * 16 + fr) * 72 + ks * 32 + fq * 8), vb = *(const bf16x8*)(VT + (et * 16 + fr) * 72 + ks * 32 + fq * 8); acc2 = mfma16(sa, vb, acc2); }
#pragma unroll
        for (int j = 0; j < 4; ++j) num[i][j] = aA[tt * 16 + fq * 4 + j] * acc1[j] + acc2[j]; }
    __syncthreads();
#pragma unroll
    for (int i = 0; i < 4; ++i)
#pragma unroll
        for (int j = 0; j < 4; ++j) { const int t = tt * 16 + fq * 4 + j; Hs[t * 132 + (eh * 4 + i) * 16 + fr] = num[i][j] / dnA[t]; }
    __syncthreads();
    { const int t = tid >> 3, sub = tid & 7, e0 = sub * 16; f32x4 hv[4]; float ss = 0.f;
#pragma unroll
        for (int j = 0; j < 4; ++j) { hv[j] = *(const f32x4*)(Hs + t * 132 + e0 + 4 * j); ss += (hv[j][0] * hv[j][0] + hv[j][1] * hv[j][1]) + (hv[j][2] * hv[j][2] + hv[j][3] * hv[j][3]); }
        ss += __shfl_xor(ss, 1); ss += __shfl_xor(ss, 2); ss += __shfl_xor(ss, 4);
        const float rstd = rsqrtf(ss * (1.f / 128.f) + EPS);
        const u32x4 o0 = *(const u32x4*)(Z + (size_t)(r0 + t) * NZ + 1536 + h * 128 + e0), o1 = *(const u32x4*)(Z + (size_t)(r0 + t) * NZ + 1536 + h * 128 + e0 + 8);
        u32x4 w0, w1;
#pragma unroll
        for (int j = 0; j < 2; ++j) { const f32x4 gh = *(const f32x4*)(a.g_head + e0 + 4 * j);
            w0[2 * j] = pk2(hv[j][0] * rstd * gh[0] * sigmoidf_(bflo(o0[2 * j])), hv[j][1] * rstd * gh[1] * sigmoidf_(bfhi(o0[2 * j])));
            w0[2 * j + 1] = pk2(hv[j][2] * rstd * gh[2] * sigmoidf_(bflo(o0[2 * j + 1])), hv[j][3] * rstd * gh[3] * sigmoidf_(bfhi(o0[2 * j + 1]))); }
#pragma unroll
        for (int j = 0; j < 2; ++j) { const f32x4 gh = *(const f32x4*)(a.g_head + e0 + 8 + 4 * j);
            w1[2 * j] = pk2(hv[2 + j][0] * rstd * gh[0] * sigmoidf_(bflo(o1[2 * j])), hv[2 + j][1] * rstd * gh[1] * sigmoidf_(bfhi(o1[2 * j])));
            w1[2 * j + 1] = pk2(hv[2 + j][2] * rstd * gh[2] * sigmoidf_(bflo(o1[2 * j + 1])), hv[2 + j][3] * rstd * gh[3] * sigmoidf_(bfhi(o1[2 * j + 1]))); }
        *(u32x4*)(MIX + (size_t)(r0 + t) * D + h * 128 + e0) = w0; *(u32x4*)(MIX + (size_t)(r0 + t) * D + h * 128 + e0 + 8) = w1; }
    __syncthreads();
}

__device__ __forceinline__ void phase6(const Args& a, int gw, int NGW, int lane) {
    const float* MOD = (const float*)(a.ws + WS_MOD); const float* T1 = (const float*)(a.ws + WS_T1); bf16* HN = (bf16*)(a.ws + WS_H);
    for (int row = gw; row < MT; row += NGW) {
        const float* xr = row < MP ? a.x_prompt + (size_t)row * D : a.x_sample + (size_t)(row - MP) * D;
        const float* md = MOD + (size_t)mod_row(row) * MODC; const float* tr = T1 + (size_t)row * D; float* orow = a.out + (size_t)row * D;
        f32x4 t[4], x1[4]; float ss = 0.f;
#pragma unroll
        for (int j = 0; j < 4; ++j) { t[j] = *(const f32x4*)(tr + j * 256 + lane * 4); ss += (t[j][0] * t[j][0] + t[j][1] * t[j][1]) + (t[j][2] * t[j][2] + t[j][3] * t[j][3]); }
        const float rstd = rsqrtf(wave_sum(ss) * (1.f / D) + EPS); float ss2 = 0.f;
#pragma unroll
        for (int j = 0; j < 4; ++j) { const int col = j * 256 + lane * 4;
            const f32x4 xv = *(const f32x4*)(xr + col), gp = *(const f32x4*)(a.g_post1 + col), ga = *(const f32x4*)(md + 2 * D + col);
            x1[j] = xv + ga * (t[j] * rstd * gp); *(f32x4*)(orow + col) = x1[j];
            ss2 += (x1[j][0] * x1[j][0] + x1[j][1] * x1[j][1]) + (x1[j][2] * x1[j][2] + x1[j][3] * x1[j][3]); }
        const float rstd2 = rsqrtf(wave_sum(ss2) * (1.f / D) + EPS);
#pragma unroll
        for (int j = 0; j < 4; ++j) { const int col = j * 256 + lane * 4;
            const f32x4 gp = *(const f32x4*)(a.g_pre2 + col), sh = *(const f32x4*)(md + 3 * D + col), sc = *(const f32x4*)(md + 4 * D + col);
            const f32x4 h = x1[j] * rstd2 * gp * (sc + 1.f) + sh;
            u32x2 o; o.x = pk2(h[0], h[1]); o.y = pk2(h[2], h[3]); *(u32x2*)(HN + (size_t)row * D + col) = o; }
    }
}

__device__ __forceinline__ void phase9(const Args& a, int gw, int NGW, int lane) {
    const float* MOD = (const float*)(a.ws + WS_MOD); const bf16* T2 = (const bf16*)(a.ws + WS_T2);
    for (int row = gw; row < MT; row += NGW) {
        const float* md = MOD + (size_t)mod_row(row) * MODC; const bf16* tr = T2 + (size_t)row * D; float* orow = a.out + (size_t)row * D;
        f32x4 t[4]; float ss = 0.f;
#pragma unroll
        for (int j = 0; j < 4; ++j) { const u32x2 w = *(const u32x2*)(tr + j * 256 + lane * 4); t[j] = (f32x4){bflo(w.x), bfhi(w.x), bflo(w.y), bfhi(w.y)};
            ss += (t[j][0] * t[j][0] + t[j][1] * t[j][1]) + (t[j][2] * t[j][2] + t[j][3] * t[j][3]); }
        const float rstd = rsqrtf(wave_sum(ss) * (1.f / D) + EPS);
#pragma unroll
        for (int j = 0; j < 4; ++j) { const int col = j * 256 + lane * 4;
            const f32x4 xv = *(const f32x4*)(orow + col), gp = *(const f32x4*)(a.g_post2 + col), ga = *(const f32x4*)(md + 5 * D + col);
            *(f32x4*)(orow + col) = xv + ga * (t[j] * rstd * gp); }
    }
}

#define LAS __attribute__((address_space(3)))
#define XB_TMO      128
#define XB_XCNT(j)  (256  + 64 * (j))
#define XB_XSUB(j)  (1280 + 64 * (j))
#define XB_XGEN(j)  (2304 + 64 * (j))
#define XB_TOP      3328
#define XB_TOPGEN   3392
#define XCD_BAR_WORDS 3456
#define XB_SPIN_CAP (1u << 18)

__device__ __forceinline__ unsigned xb_ld(unsigned* p)              { return __hip_atomic_load(p, __ATOMIC_RELAXED, __HIP_MEMORY_SCOPE_AGENT); }
__device__ __forceinline__ unsigned xb_add(unsigned* p, unsigned v) { return __hip_atomic_fetch_add(p, v, __ATOMIC_RELAXED, __HIP_MEMORY_SCOPE_AGENT); }
__device__ __forceinline__ unsigned xb_xcc_id() { return (unsigned)__builtin_amdgcn_s_getreg((3 << 11) | 20) & 0xFu; }
#define XB_SPIN(cond, bar) do { unsigned _sp = 0; while (cond) { __builtin_amdgcn_s_sleep(1); \
    if ((++_sp & 255u) == 0u) { if (xb_ld(&(bar)[XB_TMO])) break; if (_sp > XB_SPIN_CAP) { atomicAdd(&(bar)[XB_TMO], 1u); break; } } } } while (0)

struct XcdBarrier {
    unsigned* bar; unsigned x;
    volatile LAS unsigned* st;
};

__device__ __forceinline__ XcdBarrier xcd_barrier_post(unsigned* bar, volatile LAS unsigned* st) {
    XcdBarrier b; b.bar = bar; b.x = xb_xcc_id(); b.st = st;
    if (threadIdx.x == 0) (void)xb_add(&bar[XB_XCNT(b.x)], 1u);
    return b;
}
__device__ __forceinline__ void xcd_barrier_complete(unsigned* bar, unsigned x, unsigned& nloc, unsigned& nx) {
    const unsigned G = gridDim.x * gridDim.y * gridDim.z;
    unsigned sum, cnt, mine, sp = 0u;
    for (;;) {
        sum = 0u; cnt = 0u; mine = 0u;
#pragma unroll
        for (unsigned j = 0; j < 16; ++j) { const unsigned c = xb_ld(&bar[XB_XCNT(j)]); sum += c; cnt += (c > 0u) ? 1u : 0u; mine = (j == x) ? c : mine; }
        if (sum == G) break;
        __builtin_amdgcn_s_sleep(1);
        if ((++sp & 255u) == 0u) { if (xb_ld(&bar[XB_TMO])) break; if (sp > XB_SPIN_CAP) { atomicAdd(&bar[XB_TMO], 1u); break; } }
    }
    nloc = mine > 0u ? mine : 1u; nx = cnt > 0u ? cnt : 1u;
}

__device__ __forceinline__ void xcd_barrier(const XcdBarrier& b) {
    asm volatile("s_waitcnt vmcnt(0)" ::: "memory");
    __syncthreads();
    if (threadIdx.x == 0) {
        unsigned* bar = b.bar;
        __builtin_amdgcn_s_waitcnt(0);
        unsigned nloc = b.st[0], nx = b.st[1];
        if (nloc == 0u) { xcd_barrier_complete(bar, b.x, nloc, nx); b.st[0] = nloc; b.st[1] = nx; }
        const unsigned old = xb_add(&bar[XB_XSUB(b.x)], 1u);
        const unsigned gen = old / nloc;
        if (old + 1u == (gen + 1u) * nloc) {
            __builtin_amdgcn_fence(__ATOMIC_RELEASE, "agent");
            asm volatile("s_waitcnt vmcnt(0)" ::: "memory");
            const unsigned og = xb_add(&bar[XB_TOP], 1u);
            const unsigned tg = og / nx;
            if (og + 1u == (tg + 1u) * nx) xb_add(&bar[XB_TOPGEN], 1u);
            else XB_SPIN(xb_ld(&bar[XB_TOPGEN]) == tg, bar);
            __builtin_amdgcn_fence(__ATOMIC_ACQUIRE, "agent");
            xb_add(&bar[XB_XGEN(b.x)], 1u);
            asm volatile("s_waitcnt vmcnt(0)" ::: "memory");
        } else {
            XB_SPIN(xb_ld(&bar[XB_XGEN(b.x)]) == gen, bar);
            __builtin_amdgcn_fence(__ATOMIC_ACQUIRE, "agent");
            asm volatile("s_waitcnt vmcnt(0)" ::: "memory");
        }
    }
    __syncthreads();
}

__global__ void __launch_bounds__(NWAVES * 64, 2) mk_fwd(Args a) {
    extern __shared__ __attribute__((aligned(16))) unsigned char lds[];
    cg::grid_group grid = cg::this_grid();
    const int tid = threadIdx.x, lane = tid & 63, wave = __builtin_amdgcn_readfirstlane(tid >> 6);
    const int G = gridDim.x, gw = blockIdx.x * NWAVES + wave, NGW = G * NWAVES;
    const int gwr = (G - 1 - (int)blockIdx.x) * NWAVES + wave;
    PG8_LAS unsigned char* ldsl = (PG8_LAS unsigned char*)lds;
    unsigned char* ws = a.ws;
    const int lo = a.ph_lo, hi = a.ph_hi;
    if (lo > 1000) grid.sync();
    if (tid < 64) ((unsigned*)(lds + 131072))[tid] = 0u;
    __syncthreads();
    XcdBarrier bar = xcd_barrier_post((unsigned*)ws + CW_BAR, (volatile LAS unsigned*)(lds + 131072) + 8);
#define IN(k) (lo <= (k) && (k) < hi)
#define GSYNC() xcd_barrier(bar)
#define SEAM(k) do { if (IN(k) && IN((k) + 1)) GSYNC(); } while (0)
#ifndef PROBE_MASK
#define PROBE_MASK 0
#endif
#ifndef PROBE_SYNCS
#define PROBE_SYNCS 0
#endif
#define REPS(k) (((PROBE_MASK >> (k)) & 1) ? 2 : 0)
#define PRE(k) for (int rep_ = 0; rep_ < REPS(k); ++rep_)
    for (int i_ = 0; i_ < PROBE_SYNCS; ++i_) GSYNC();

    PRE(0) {
        if (IN(0)) phase0(a, lds, gw, NGW, lane, wave);
        GSYNC(); }
    if (IN(0)) phase0(a, lds, gw, NGW, lane, wave);
    SEAM(0);
    PRE(1) {
        if (IN(1)) small_gemm<0>((const bf16*)(ws + WS_SILU), (const bf16*)(ws + WS_WADA), MODC, D, NMODP / 16, gw, NGW, lane, ws + WS_MOD, a.b_ada);
        GSYNC(); }
    if (IN(1)) small_gemm<0>((const bf16*)(ws + WS_SILU), (const bf16*)(ws + WS_WADA), MODC, D, NMODP / 16, gw, NGW, lane, ws + WS_MOD, a.b_ada);
    SEAM(1);
    PRE(2) {
        if (IN(2)) phase1a(a, lds, gw, NGW, lane, tid);
        GSYNC(); }
    if (IN(2)) phase1a(a, lds, gw, NGW, lane, tid);
    SEAM(2);
    PRE(3) {
        if (IN(3)) {
            pg8::Gemm g{(const bf16*)(ws + WS_H), (const bf16*)(ws + WS_WIN), MP, NZ, D}; pg8::StaticOrder S; S.init(MP, NZ, G, (int)blockIdx.x);
            pg8::EpiB16<0> E{(bf16*)(ws + WS_Z), NZ};
            pg8::gemm_phase<pg8::EpiB16<0>, pg8::StaticOrder, true, true>(ldsl, g, S, E);
            small_gemm<1>((const bf16*)(ws + WS_H) + (size_t)MP * D, (const bf16*)(ws + WS_WIN), NZ, D, MS / 16, gwr, NGW, lane, (bf16*)(ws + WS_Z) + (size_t)MP * NZ, nullptr);
        }
        GSYNC(); }
    if (IN(3)) {
        pg8::Gemm g{(const bf16*)(ws + WS_H), (const bf16*)(ws + WS_WIN), MP, NZ, D}; pg8::StaticOrder S; S.init(MP, NZ, G, (int)blockIdx.x);
        pg8::EpiB16<0> E{(bf16*)(ws + WS_Z), NZ};
        pg8::gemm_phase<pg8::EpiB16<0>, pg8::StaticOrder, true, true>(ldsl, g, S, E);
        small_gemm<1>((const bf16*)(ws + WS_H) + (size_t)MP * D, (const bf16*)(ws + WS_WIN), NZ, D, MS / 16, gwr, NGW, lane, (bf16*)(ws + WS_Z) + (size_t)MP * NZ, nullptr);
    }
    SEAM(3);
    PRE(4) {
        if (IN(4)) phase2(a, lds, tid, lane, wave);
        GSYNC(); }
    if (IN(4)) phase2(a, lds, tid, lane, wave);
    SEAM(4);
    PRE(5) {
        if (IN(5)) phase3(a, tid);
        GSYNC(); }
    if (IN(5)) phase3(a, tid);
    SEAM(5);
    PRE(6) {
        if (IN(6)) { for (int it = blockIdx.x; it < NITEM; it += G) p4_item(a, lds, it, tid, lane, wave); }
        GSYNC(); }
    if (IN(6)) { for (int it = blockIdx.x; it < NITEM; it += G) p4_item(a, lds, it, tid, lane, wave); }
    SEAM(6);
    PRE(7) {
        if (IN(7)) {
            pg8::Gemm g{(const bf16*)(ws + WS_H), (const bf16*)(ws + WS_WOUT), MP, D, D}; pg8::StaticOrder S; S.init(MP, D, G, (int)blockIdx.x);
            pg8::EpiF32 E{(float*)(ws + WS_T1), D};
            pg8::gemm_phase<pg8::EpiF32, pg8::StaticOrder, false, true>(ldsl, g, S, E);
            small_gemm<2>((const bf16*)(ws + WS_H) + (size_t)MP * D, (const bf16*)(ws + WS_WOUT), D, D, MS / 16, gw, NGW, lane, (float*)(ws + WS_T1) + (size_t)MP * D, nullptr);
        }
        GSYNC(); }
    if (IN(7)) {
        pg8::Gemm g{(const bf16*)(ws + WS_H), (const bf16*)(ws + WS_WOUT), MP, D, D}; pg8::StaticOrder S; S.init(MP, D, G, (int)blockIdx.x);
        pg8::EpiF32 E{(float*)(ws + WS_T1), D};
        pg8::gemm_phase<pg8::EpiF32, pg8::StaticOrder, false, true>(ldsl, g, S, E);
        small_gemm<2>((const bf16*)(ws + WS_H) + (size_t)MP * D, (const bf16*)(ws + WS_WOUT), D, D, MS / 16, gw, NGW, lane, (float*)(ws + WS_T1) + (size_t)MP * D, nullptr);
    }
    SEAM(7);
    PRE(8) {
        if (IN(8)) phase6(a, gw, NGW, lane);
        GSYNC(); }
    if (IN(8)) phase6(a, gw, NGW, lane);
    SEAM(8);
    PRE(9) {
        if (IN(9)) {
            pg8::Gemm g{(const bf16*)(ws + WS_H), (const bf16*)(ws + WS_WUP), MP, FF, D}; pg8::StaticOrder S; S.init(MP, FF, G, (int)blockIdx.x);
            pg8::EpiB16<1> E{(bf16*)(ws + WS_F), FF};
            pg8::gemm_phase<pg8::EpiB16<1>, pg8::StaticOrder, true, true>(ldsl, g, S, E);
            small_gemm<3>((const bf16*)(ws + WS_H) + (size_t)MP * D, (const bf16*)(ws + WS_WUP), FF, D, MS / 16, gw, NGW, lane, (bf16*)(ws + WS_F) + (size_t)MP * FF, nullptr);
        }
        GSYNC(); }
    if (IN(9)) {
        pg8::Gemm g{(const bf16*)(ws + WS_H), (const bf16*)(ws + WS_WUP), MP, FF, D}; pg8::StaticOrder S; S.init(MP, FF, G, (int)blockIdx.x);
        pg8::EpiB16<1> E{(bf16*)(ws + WS_F), FF};
        pg8::gemm_phase<pg8::EpiB16<1>, pg8::StaticOrder, true, true>(ldsl, g, S, E);
        small_gemm<3>((const bf16*)(ws + WS_H) + (size_t)MP * D, (const bf16*)(ws + WS_WUP), FF, D, MS / 16, gw, NGW, lane, (bf16*)(ws + WS_F) + (size_t)MP * FF, nullptr);
    }
    SEAM(9);
    PRE(10) {
        if (IN(10)) {
            pg8::Gemm g{(const bf16*)(ws + WS_F), (const bf16*)(ws + WS_WDN), MP, D, FF}; pg8::StaticOrder S; S.init(MP, D, G, (int)blockIdx.x);
            pg8::EpiB16<0> E{(bf16*)(ws + WS_T2), D};
            pg8::gemm_phase<pg8::EpiB16<0>, pg8::StaticOrder, false, true>(ldsl, g, S, E);
            small_gemm<4>((const bf16*)(ws + WS_F) + (size_t)MP * FF, (const bf16*)(ws + WS_WDN), D, FF, MS / 16, gw, NGW, lane, (bf16*)(ws + WS_T2) + (size_t)MP * D, nullptr);
        }
        GSYNC(); }
    if (IN(10)) {
        pg8::Gemm g{(const bf16*)(ws + WS_F), (const bf16*)(ws + WS_WDN), MP, D, FF}; pg8::StaticOrder S; S.init(MP, D, G, (int)blockIdx.x);
        pg8::EpiB16<0> E{(bf16*)(ws + WS_T2), D};
        pg8::gemm_phase<pg8::EpiB16<0>, pg8::StaticOrder, false, true>(ldsl, g, S, E);
        small_gemm<4>((const bf16*)(ws + WS_F) + (size_t)MP * FF, (const bf16*)(ws + WS_WDN), D, FF, MS / 16, gw, NGW, lane, (bf16*)(ws + WS_T2) + (size_t)MP * D, nullptr);
    }
    SEAM(10);
    if (IN(11)) phase9(a, gw, NGW, lane);
#undef IN
#undef SEAM
}

#ifndef MK_SPLIT
#define MK_SPLIT 0
#endif
extern "C" void kernel_launch(void* const* d_in, const int* in_sizes, int n_in, void* d_out, int out_size, void* d_ws, size_t ws_size, hipStream_t stream) {
    static int grid = 0;
    if (grid == 0) {
        int dev = 0, cus = 0, per_cu = 0;
        if (hipGetDevice(&dev) != hipSuccess || hipDeviceGetAttribute(&cus, hipDeviceAttributeMultiprocessorCount, dev) != hipSuccess) { fprintf(stderr, "kernel_launch: device query failed\n"); grid = -1; return; }
        if (hipFuncSetAttribute((const void*)mk_fwd, hipFuncAttributeMaxDynamicSharedMemorySize, LDS_BYTES) != hipSuccess) { fprintf(stderr, "kernel_launch: hipFuncSetAttribute failed\n"); grid = -1; return; }
        if (hipOccupancyMaxActiveBlocksPerMultiprocessor(&per_cu, (const void*)mk_fwd, NWAVES * 64, LDS_BYTES) != hipSuccess || per_cu < 1) { fprintf(stderr, "kernel_launch: occupancy query says %d\n", per_cu); per_cu = 1; }
        (void)hipGetLastError();
        grid = cus;
        if (n_in != 23 || out_size != (int)O_END || ws_size < 256 * MiB) fprintf(stderr, "kernel_launch: unexpected sizes n_in %d out %d ws %zu\n", n_in, out_size, ws_size);
    }
    if (grid < 0) return;
    Args a{};
    const float** pp = (const float**)&a;
    for (int i = 0; i < 23; ++i) pp[i] = (const float*)d_in[i];
    a.out = (float*)d_out; a.ws = (unsigned char*)d_ws;
    if (hipMemsetAsync(d_ws, 0, CTL_ZERO_BYTES, stream) != hipSuccess) { fprintf(stderr, "kernel_launch: memset failed\n"); return; }
#if MK_SPLIT
    for (int p = 0; p < 12; ++p) { a.ph_lo = p; a.ph_hi = p + 1; hipLaunchKernelGGL(mk_fwd, dim3(grid), dim3(NWAVES * 64), LDS_BYTES, stream, a); }
#else
    a.ph_lo = 0; a.ph_hi = 12;
    void* args[] = {&a};
    hipError_t e = hipLaunchCooperativeKernel((const void*)mk_fwd, dim3(grid), dim3(NWAVES * 64), args, LDS_BYTES, stream);
    if (e != hipSuccess) fprintf(stderr, "cooperative launch failed: %s (grid %d)\n", hipGetErrorString(e), grid);
#endif
}
```

```cpp
#include <hip/hip_runtime.h>
#include <hip/hip_cooperative_groups.h>
#include <cstdio>
#include <cstdint>
namespace cg = cooperative_groups;
namespace pg8 {
#define PG8_LAS __attribute__((address_space(3)))
typedef unsigned short bf16_t;
typedef short bf16x8 __attribute__((ext_vector_type(8)));
typedef float f32x4 __attribute__((ext_vector_type(4)));
typedef unsigned u32x4 __attribute__((ext_vector_type(4)));
constexpr int BM = 256, BK = 64, HALF = 128, HTB = HALF * BK * 2  , STAGE_BYTES = 8 * HTB, NXCD = 8, WGM = 8;

__host__ __device__ __forceinline__ int lds_byte(int r, int c) { const int st = (r >> 4) * 2 + (c >> 5), rr = r & 15, cc = c & 31, ob = rr * 64 + cc * 2; return st * 1024 + (ob ^ (((ob >> 9) & 1) << 5)); }
__host__ __device__ __forceinline__ void stage_rc(int b, int& R, int& C) { const int st = b / 1024, sb = b % 1024, swz = sb ^ (((sb >> 9) & 1) << 5); R = (st >> 1) * 16 + swz / 64; C = (st & 1) * 32 + (swz % 64) / 2; }
__host__ __device__ __forceinline__ int perm32(int rho) { const int n = rho >> 4, i = rho & 15; return 8 * (i >> 2) + 4 * n + (i & 3); }

struct Unit { int pm, pn; };
struct Gemm { const bf16_t* A; const bf16_t* Bt; int M, N, K; };

struct StaticOrder {
    int nM, nN, nwg, G, c;
    __host__ __device__ void init(int M, int N, int G_, int c_) { nM = M / BM; nN = N / BM; nwg = nM * nN; G = G_; c = c_; }
    __host__ __device__ bool next(int i, Unit& u) const {
        const long L = (long)i * G + c; if (L >= nwg) return false;
        int wgid = (int)L; { const int q = nwg / NXCD, r = nwg % NXCD, xcd = wgid % NXCD, off = wgid / NXCD; wgid = (xcd < r ? xcd * (q + 1) : r * (q + 1) + (xcd - r) * q) + off; }
        const int nig = WGM * nN, gid = wgid / nig, fm = gid * WGM, gsz = (nM - fm) < WGM ? (nM - fm) : WGM;
        u.pm = fm + ((wgid % nig) % gsz); u.pn = (wgid % nig) / gsz; return true;
    }
    __device__ __forceinline__ void a_ready(const Unit&) const {}
    __device__ __forceinline__ void done(const Unit&) const {}
};

__device__ __forceinline__ unsigned cvt_pk_bf16(float lo, float hi) { unsigned r; asm volatile("v_cvt_pk_bf16_f32 %0, %1, %2" : "=v"(r) : "v"(lo), "v"(hi)); return r; }
template <int ACT  > struct EpiB16 {
    static constexpr bool PERM = true, AFTER_DRAIN = false;
    bf16_t* O; int ldc;
    __device__ __forceinline__ void operator()(const f32x4 (&acc)[2][2][4][2], const Unit& u, int wr, int wc, int fr, int fq) const {
        const int row0 = u.pm * BM + wr * 64 + fr; const int col0 = u.pn * BM + wc * 32 + 8 * fq;
#pragma unroll
        for (int ai = 0; ai < 2; ++ai)
#pragma unroll
            for (int m = 0; m < 4; ++m) { bf16_t* rowp = O + (size_t)(row0 + ai * HALF + m * 16) * ldc + col0;
#pragma unroll
                for (int bj = 0; bj < 2; ++bj) { f32x4 v0 = acc[ai][bj][m][0], v1 = acc[ai][bj][m][1];
                    if (ACT == 1) {
#pragma unroll
                        for (int i = 0; i < 4; ++i) { float a = fmaxf(v0[i], 0.f), b = fmaxf(v1[i], 0.f); v0[i] = a * a; v1[i] = b * b; } }
                    u32x4 w; w.x = cvt_pk_bf16(v0[0], v0[1]); w.y = cvt_pk_bf16(v0[2], v0[3]); w.z = cvt_pk_bf16(v1[0], v1[1]); w.w = cvt_pk_bf16(v1[2], v1[3]);
                    *(u32x4*)(rowp + bj * HALF) = w; } }
    }
};
struct EpiF32 {
    static constexpr bool PERM = false, AFTER_DRAIN = false;
    float* O; int ldc;
    __device__ __forceinline__ void operator()(const f32x4 (&acc)[2][2][4][2], const Unit& u, int wr, int wc, int fr, int fq) const {
#pragma unroll
        for (int ai = 0; ai < 2; ++ai)
#pragma unroll
            for (int m = 0; m < 4; ++m) { float* rowp = O + (size_t)(u.pm * BM + ai * HALF + wr * 64 + m * 16 + fr) * ldc + u.pn * BM + wc * 32 + 4 * fq;
#pragma unroll
                for (int bj = 0; bj < 2; ++bj)
#pragma unroll
                    for (int n = 0; n < 2; ++n) *(f32x4*)(rowp + bj * HALF + n * 16) = acc[ai][bj][m][n]; }
    }
};
struct EpiB16CM {
    static constexpr bool PERM = true, AFTER_DRAIN = false;
    bf16_t* O; int R;
    __device__ __forceinline__ void operator()(const f32x4 (&acc)[2][2][4][2], const Unit& u, int wr, int wc, int fr, int fq) const {
        const int row0 = u.pm * BM + wr * 64 + fr; const int col0 = u.pn * BM + wc * 32 + 8 * fq;
#pragma unroll
        for (int bj = 0; bj < 2; ++bj) { bf16_t* pl = O + ((size_t)((col0 + bj * HALF) >> 3) * R + row0) * 8;
#pragma unroll
            for (int ai = 0; ai < 2; ++ai)
#pragma unroll
                for (int m = 0; m < 4; ++m) { const f32x4 v0 = acc[ai][bj][m][0], v1 = acc[ai][bj][m][1];
                    u32x4 w; w.x = cvt_pk_bf16(v0[0], v0[1]); w.y = cvt_pk_bf16(v0[2], v0[3]); w.z = cvt_pk_bf16(v1[0], v1[1]); w.w = cvt_pk_bf16(v1[2], v1[3]);
                    *(u32x4*)(pl + (size_t)(ai * HALF + m * 16) * 8) = w; } }
    }
};
template <class Epi, class Sched, bool ALIGN_EPI = false, bool SP2 = false>
__device__ __forceinline__ void gemm_phase(PG8_LAS unsigned char* lds, const Gemm g, const Sched& S, const Epi& E) {
    const int tid = threadIdx.x, wid = __builtin_amdgcn_readfirstlane(tid >> 6), lane = tid & 63, wr = wid >> 2, wc = wid & 3, fr = lane & 15, fq = lane >> 4;
    const int K = g.K, nt = K / BK;
    unsigned voffA[2], voffB[2];
#pragma unroll
    for (int i = 0; i < 2; ++i) { int R, C; stage_rc(tid * 16 + i * 8192, R, C); const int Rb = Epi::PERM ? ((R & ~31) + perm32(R & 31)) : R;
        voffA[i] = (unsigned)(R * K + C) * 2u; voffB[i] = (unsigned)(Rb * K + C) * 2u; }
    const size_t kstep = (size_t)(BK * 2);
    const size_t hstep = (size_t)HALF * K * 2;
    const size_t tstep = 2 * hstep;
    const unsigned ldsw = (unsigned)wid * 1024u;
    const int aoff = lds_byte(wr * 64 + fr, fq * 8), boff = lds_byte(wc * 32 + fr, fq * 8);
#define PG8_SA(b, h) (((b) * 2 + (h)) * HTB)
#define PG8_SB(b, h) ((4 + (b) * 2 + (h)) * HTB)
#define PG8_STAGE(bufoff, gbase, voff) do { _Pragma("unroll") for (int _i = 0; _i < 2; ++_i) \
        __builtin_amdgcn_global_load_lds((const unsigned*)((const char*)(gbase) + (voff)[_i]), (PG8_LAS unsigned*)(lds + (bufoff) + ldsw + _i * 8192), 16, 0, 0); } while (0)
#define PG8_LDA(dst, b, h) do { _Pragma("unroll") for (int m = 0; m < 4; ++m) _Pragma("unroll") for (int k = 0; k < 2; ++k) dst[m][k] = *(const PG8_LAS bf16x8*)(lds + PG8_SA(b, h) + aoff + m * 2048 + k * 1024); } while (0)
#define PG8_LDB(dst, b, h) do { _Pragma("unroll") for (int n = 0; n < 2; ++n) _Pragma("unroll") for (int k = 0; k < 2; ++k) dst[n][k] = *(const PG8_LAS bf16x8*)(lds + PG8_SB(b, h) + boff + n * 2048 + k * 1024); } while (0)
#define PG8_MMA(ai, bj, At, Bt) do { __builtin_amdgcn_s_setprio(1); _Pragma("unroll") for (int m = 0; m < 4; ++m) _Pragma("unroll") for (int n = 0; n < 2; ++n) _Pragma("unroll") for (int k = 0; k < 2; ++k) \
        acc[ai][bj][m][n] = __builtin_amdgcn_mfma_f32_16x16x32_bf16(Bt[n][k], At[m][k], acc[ai][bj][m][n], 0, 0, 0); __builtin_amdgcn_s_setprio(0); } while (0)
#define PG8_WAIT_V(n) asm volatile("s_waitcnt vmcnt(" #n ")" ::: "memory")
#define PG8_WAIT_L(n) asm volatile("s_waitcnt lgkmcnt(" #n ")" ::: "memory")
#define PG8_BAR __builtin_amdgcn_s_barrier()
#define PG8_SCHED __builtin_amdgcn_sched_barrier(0)
    Unit cur, nxt; int ui = 0;
    if (!S.next(0, cur)) return;
    f32x4 acc[2][2][4][2];
#pragma unroll
    for (int a = 0; a < 2; ++a)
#pragma unroll
        for (int b = 0; b < 2; ++b)
#pragma unroll
            for (int m = 0; m < 4; ++m)
#pragma unroll
                for (int n = 0; n < 2; ++n) acc[a][b][m][n] = (f32x4){0.f, 0.f, 0.f, 0.f};
    bf16x8 At[4][2], B0[2][2], B1[2][2];
    const char* cA = (const char*)g.A + (size_t)cur.pm * tstep; const char* cB = (const char*)g.Bt + (size_t)cur.pn * tstep;
    S.a_ready(cur);
    if constexpr (SP2) {
        PG8_STAGE(PG8_SB(0, 0), cB, voffB); PG8_STAGE(PG8_SB(0, 1), cB + hstep, voffB); PG8_STAGE(PG8_SA(0, 0), cA, voffA); PG8_STAGE(PG8_SA(0, 1), cA + hstep, voffA);
        if (wr == 1) PG8_BAR;
        PG8_WAIT_V(2); PG8_BAR;
        PG8_STAGE(PG8_SB(1, 0), cB + kstep, voffB); PG8_STAGE(PG8_SA(1, 0), cA + kstep, voffA); PG8_STAGE(PG8_SB(1, 1), cB + hstep + kstep, voffB);
        PG8_WAIT_V(6); PG8_BAR;
    } else {
        PG8_STAGE(PG8_SB(0, 0), cB, voffB); PG8_STAGE(PG8_SA(0, 0), cA, voffA); PG8_STAGE(PG8_SB(0, 1), cB + hstep, voffB); PG8_STAGE(PG8_SA(0, 1), cA + hstep, voffA);
        if (wr == 1) PG8_BAR;
        PG8_WAIT_V(4); PG8_BAR;
        PG8_STAGE(PG8_SB(1, 0), cB + kstep, voffB); PG8_STAGE(PG8_SA(1, 0), cA + kstep, voffA); PG8_STAGE(PG8_SB(1, 1), cB + hstep + kstep, voffB);
        PG8_WAIT_V(6); PG8_BAR;
    }
    for (;;) {
        const bool has_next = S.next(ui + 1, nxt);
        const char* nA = has_next ? (const char*)g.A + (size_t)nxt.pm * tstep : cA; const char* nB = has_next ? (const char*)g.Bt + (size_t)nxt.pn * tstep : cB;
        for (int t = 0; t < nt; t += 2) {
            const bool last = (t == nt - 2);
            const char* a1 = cA + (size_t)(t + 1) * kstep;
            const char* a2 = last ? nA : cA + (size_t)(t + 2) * kstep; const char* b2 = last ? nB : cB + (size_t)(t + 2) * kstep;
            const char* a3 = a2 + kstep; const char* b3 = b2 + kstep;
            if (last && has_next) S.a_ready(nxt);
            if constexpr (SP2) {
            PG8_LDB(B0, 0, 0); PG8_LDB(B1, 0, 1); PG8_SCHED; PG8_LDA(At, 0, 0); PG8_STAGE(PG8_SA(1, 1), a1 + hstep, voffA);
            PG8_WAIT_V(8); PG8_WAIT_L(0); PG8_BAR; PG8_MMA(0, 0, At, B0); PG8_MMA(0, 1, At, B1); PG8_BAR; PG8_SCHED;
            PG8_LDA(At, 0, 1); PG8_STAGE(PG8_SB(0, 0), b2, voffB); PG8_STAGE(PG8_SB(0, 1), b2 + hstep, voffB); PG8_STAGE(PG8_SA(0, 0), a2, voffA);
            PG8_WAIT_V(8); PG8_WAIT_L(0); PG8_BAR; PG8_MMA(1, 0, At, B0); PG8_MMA(1, 1, At, B1); PG8_BAR; PG8_SCHED;
            PG8_LDB(B0, 1, 0); PG8_LDB(B1, 1, 1); PG8_SCHED; PG8_LDA(At, 1, 0); PG8_STAGE(PG8_SA(0, 1), a2 + hstep, voffA);
            PG8_WAIT_V(8); PG8_WAIT_L(0); PG8_BAR; PG8_MMA(0, 0, At, B0); PG8_MMA(0, 1, At, B1); PG8_BAR; PG8_SCHED;
            PG8_LDA(At, 1, 1); PG8_STAGE(PG8_SB(1, 0), b3, voffB); PG8_STAGE(PG8_SB(1, 1), b3 + hstep, voffB); PG8_STAGE(PG8_SA(1, 0), a3, voffA);
            PG8_WAIT_V(8); PG8_WAIT_L(0); PG8_BAR; PG8_MMA(1, 0, At, B0); PG8_MMA(1, 1, At, B1); PG8_BAR; PG8_SCHED;
            } else {
            PG8_LDB(B0, 0, 0); PG8_SCHED; PG8_LDA(At, 0, 0); PG8_STAGE(PG8_SA(1, 1), a1 + hstep, voffA);
            PG8_WAIT_L(8); PG8_BAR; PG8_WAIT_L(0); PG8_MMA(0, 0, At, B0); PG8_BAR; PG8_SCHED;
            PG8_LDB(B1, 0, 1); PG8_STAGE(PG8_SB(0, 0), b2, voffB);
            PG8_BAR; PG8_WAIT_L(0); PG8_MMA(0, 1, At, B1); PG8_BAR;
            PG8_LDA(At, 0, 1); PG8_STAGE(PG8_SA(0, 0), a2, voffA);
            PG8_BAR; PG8_WAIT_L(0); PG8_MMA(1, 0, At, B0); PG8_BAR; PG8_SCHED;
            PG8_STAGE(PG8_SB(0, 1), b2 + hstep, voffB);
            PG8_WAIT_V(6); PG8_BAR; PG8_MMA(1, 1, At, B1); PG8_BAR;
            PG8_LDB(B0, 1, 0); PG8_SCHED; PG8_LDA(At, 1, 0); PG8_STAGE(PG8_SA(0, 1), a2 + hstep, voffA);
            PG8_WAIT_L(8); PG8_BAR; PG8_WAIT_L(0); PG8_MMA(0, 0, At, B0); PG8_BAR; PG8_SCHED;
            PG8_LDB(B1, 1, 1); PG8_STAGE(PG8_SB(1, 0), b3, voffB);
            PG8_BAR; PG8_WAIT_L(0); PG8_MMA(0, 1, At, B1); PG8_BAR;
            PG8_LDA(At, 1, 1); PG8_STAGE(PG8_SA(1, 0), a3, voffA);
            PG8_BAR; PG8_WAIT_L(0); PG8_MMA(1, 0, At, B0); PG8_BAR; PG8_SCHED;
            PG8_STAGE(PG8_SB(1, 1), b3 + hstep, voffB);
            PG8_WAIT_V(6); PG8_BAR; PG8_MMA(1, 1, At, B1); PG8_BAR;
            }
        }
        if constexpr (ALIGN_EPI) { if (wr == 0) PG8_BAR; }
        if constexpr (!Epi::AFTER_DRAIN) { E(acc, cur, wr, wc, fr, fq); S.done(cur); }
        if (!has_next) break;
#pragma unroll
        for (int a = 0; a < 2; ++a)
#pragma unroll
            for (int b = 0; b < 2; ++b)
#pragma unroll
                for (int m = 0; m < 4; ++m)
#pragma unroll
                    for (int n = 0; n < 2; ++n) acc[a][b][m][n] = (f32x4){0.f, 0.f, 0.f, 0.f};
        cur = nxt; cA = nA; cB = nB; ++ui;
        if constexpr (ALIGN_EPI) { if (wr == 1) PG8_BAR; }
    }
    PG8_WAIT_V(0);
    if constexpr (!ALIGN_EPI) { if (wr == 0) PG8_BAR; }
    PG8_BAR;
    if constexpr (Epi::AFTER_DRAIN) { E.fused(acc, cur, wr, wc, fr, fq, lds, wid, lane); S.done(cur); }
#undef PG8_SA
#undef PG8_SB
#undef PG8_STAGE
#undef PG8_LDA
#undef PG8_LDB
#undef PG8_MMA
#undef PG8_WAIT_V
#undef PG8_WAIT_L
#undef PG8_BAR
#undef PG8_SCHED
}
}

constexpr int D = 1024, MP = 16384, MS = 128, MT = MP + MS, SEQ = 2048, NBATCH = 8, FF = 4096;
constexpr int NZ = 2048;
constexpr int ZR = 16400;
constexpr int ZTR = 1040;
__device__ __forceinline__ size_t zc(int row, int col) { return ((size_t)(col >> 3) * ZR + row) * 8 + (col & 7); }
__device__ __forceinline__ size_t ztc(int wrow, int tok) { return ((size_t)(tok >> 3) * ZTR + wrow) * 8 + (tok & 7); }
constexpr int NZS = 2560;
constexpr int INC = 2568;
constexpr int NMOD = 136, NMODP = 144, MODC = 6144;
constexpr int NCH = 32;
constexpr int NITEM = 1024;
constexpr float EPS = 1e-6f;
constexpr float KSCALE = 0.08838834764831845f;

constexpr size_t MiB = 1u << 20;
constexpr size_t WS_WIN = 2 * MiB, WS_WOUT = 8 * MiB, WS_WUP = 10 * MiB, WS_WDN = 18 * MiB, WS_WADA = 26 * MiB, WS_WPOOL = 38 * MiB;
constexpr size_t WS_SILU = 38 * MiB + 256 * 1024, WS_MOD = 39 * MiB, WS_GATES = 43 * MiB;
constexpr size_t WS_CHB = 44 * MiB, WS_CHM = WS_CHB + 4096, WS_MST = WS_CHM + 4096, WS_NU = 44 * MiB + 256 * 1024, WS_NST = 44 * MiB + 768 * 1024, WS_ZS = 45 * MiB + 512 * 1024;
constexpr size_t WS_H = 47 * MiB;
constexpr size_t WS_Z = 80 * MiB;
constexpr size_t WS_ZT = 146 * MiB;
constexpr size_t WS_U = 179 * MiB;
constexpr size_t WS_CST = 211 * MiB;
constexpr size_t WS_T1 = 80 * MiB;
constexpr size_t WS_F = 80 * MiB;
constexpr size_t WS_T2 = 210 * MiB;
static_assert(WS_ZS + (size_t)MS * NZS * 2 <= WS_H && WS_H + (size_t)MT * D * 2 <= WS_Z && WS_Z + (size_t)(NZ / 8) * ZR * 16 <= WS_ZT && WS_ZT + (size_t)(MP / 8) * ZTR * 16 <= WS_U && WS_U + 32 * MiB <= WS_CST && WS_CST + 32 * MiB <= 256 * MiB, "ws map");
static_assert(WS_F + (size_t)MT * FF * 2 <= WS_T2 && WS_T2 + (size_t)MT * D * 2 <= 256 * MiB && WS_T1 + (size_t)MT * D * 4 <= WS_U, "ws map 2");

constexpr size_t O_YP = 0, O_YS = 16777216, O_CP = 16908288, O_NP = 17432576, O_MP = 17436672, O_PP = 17436704, O_CS = 17498144, O_NS = 25886752, O_MS = 25952288, O_PS = 25952800, O_END = 26935840;

constexpr int LDS_BYTES = 147456;
constexpr int CW_BAR = 4096;
constexpr size_t CTL_ZERO_BYTES = 65536;
constexpr int NWAVES = 8;

typedef unsigned short bf16;
typedef unsigned u32x4 __attribute__((ext_vector_type(4)));
typedef unsigned u32x2 __attribute__((ext_vector_type(2)));
typedef float f32x4 __attribute__((ext_vector_type(4)));
typedef short bf16x8 __attribute__((ext_vector_type(8)));

struct Args {
    const float *x_prompt, *x_sample, *c_prompt, *c_sample, *state_C, *state_n, *state_m, *state_pool, *w_ada, *b_ada, *g_pre1, *g_post1, *w_in, *b_ig, *b_fg, *g_head, *w_pool,
        *pool_scale, *w_out, *g_pre2, *g_post2, *w_up, *w_down;
    float* out; unsigned char* ws;
    int ph_lo, ph_hi;
};

__device__ __forceinline__ unsigned f2bf(float f) { unsigned u = __builtin_bit_cast(unsigned, f); return (u + 0x7fffu + ((u >> 16) & 1u)) >> 16; }
typedef float f32x2_t __attribute__((ext_vector_type(2)));
typedef __bf16 bf16x2_t __attribute__((ext_vector_type(2)));
__device__ __forceinline__ unsigned pk2(float lo, float hi) { f32x2_t v = {lo, hi}; bf16x2_t b = __builtin_convertvector(v, bf16x2_t); return __builtin_bit_cast(unsigned, b); }
__device__ __forceinline__ float bf2f(unsigned h) { return __builtin_bit_cast(float, h << 16); }
__device__ __forceinline__ float bflo(unsigned w) { return __builtin_bit_cast(float, w << 16); }
__device__ __forceinline__ float bfhi(unsigned w) { return __builtin_bit_cast(float, w & 0xffff0000u); }
__device__ __forceinline__ float wave_sum(float v) {
#pragma unroll
    for (int o = 1; o < 64; o <<= 1) v += __shfl_xor(v, o);
    return v;
}
__device__ __forceinline__ float wave_max(float v) {
#pragma unroll
    for (int o = 1; o < 64; o <<= 1) v = fmaxf(v, __shfl_xor(v, o));
    return v;
}
__device__ __forceinline__ float sigmoidf_(float x) { return 1.f / (1.f + __expf(-x)); }
__device__ __forceinline__ int mod_row(int row) { return row < MP ? (row >> 11) : (NBATCH + row - MP); }
__device__ __forceinline__ f32x4 mfma16(bf16x8 a, bf16x8 b, f32x4 c) { return __builtin_amdgcn_mfma_f32_16x16x32_bf16(a, b, c, 0, 0, 0); }

__device__ __forceinline__ void transpose_item(const float* W, int ldw, int nblk, int K, bf16* WT, float* scr, int item, int lane, float scale) {
    const int kb = item / nblk, nb = item % nblk, k0 = 64 * kb, n0 = 32 * nb;
#pragma unroll 8
    for (int i = 0; i < 32; ++i) { const int kk = 2 * i + (lane >> 5); scr[kk * 33 + (lane & 31)] = W[(size_t)(k0 + kk) * ldw + n0 + (lane & 31)] * scale; }
    asm volatile("s_waitcnt lgkmcnt(0)" ::: "memory");
    const int c = lane & 7;
#pragma unroll
    for (int j = 0; j < 4; ++j) { const int n = (lane >> 3) + 8 * j; const float* s = scr + (8 * c) * 33 + n;
        u32x4 o; o.x = pk2(s[0 * 33], s[1 * 33]); o.y = pk2(s[2 * 33], s[3 * 33]); o.z = pk2(s[4 * 33], s[5 * 33]); o.w = pk2(s[6 * 33], s[7 * 33]);
        *(u32x4*)(WT + (size_t)(n0 + n) * K + k0 + 8 * c) = o; }
    asm volatile("s_waitcnt lgkmcnt(0)" ::: "memory");
}

__device__ __forceinline__ void phase0(const Args& a, unsigned char* lds, int gw, int NGW, int lane, int wave) {
    float* scr = (float*)(lds + wave * 16384);
    unsigned char* ws = a.ws;
    constexpr int I_IN = 6 * 256, I_OUT = 16 * 32, I_UP = 16 * 128, I_DN = 64 * 32, I_ADA = 16 * 192, I_POOL = 32;
    constexpr int NIT = I_IN + I_OUT + I_UP + I_DN + I_ADA + I_POOL;
    for (int it = gw; it < NIT; it += NGW) {
        int r = it;
        if (r < I_IN) { const int blk = r >> 8, rr = r & 255;
            const int src = blk == 0 ? 0 : blk == 1 ? 512 : blk == 2 ? 512 : blk == 3 ? 1024 : blk == 4 ? 1536 : 2056;
            const int dst = blk == 0 ? 0 : blk == 1 ? 512 : blk == 2 ? 2048 : blk == 3 ? 2560 : blk == 4 ? 1024 : 1536;
            transpose_item(a.w_in + src, INC, 16, D, (bf16*)(ws + WS_WIN) + (size_t)dst * D, scr, rr, lane, (blk == 1 || blk == 2) ? KSCALE : 1.f); continue; } r -= I_IN;
        if (r < I_OUT) { transpose_item(a.w_out, D, 32, D, (bf16*)(ws + WS_WOUT), scr, r, lane, 1.f); continue; } r -= I_OUT;
        if (r < I_UP) { transpose_item(a.w_up, FF, 128, D, (bf16*)(ws + WS_WUP), scr, r, lane, 1.f); continue; } r -= I_UP;
        if (r < I_DN) { transpose_item(a.w_down, D, 32, FF, (bf16*)(ws + WS_WDN), scr, r, lane, 1.f); continue; } r -= I_DN;
        if (r < I_ADA) { transpose_item(a.w_ada, MODC, 192, D, (bf16*)(ws + WS_WADA), scr, r, lane, 1.f); continue; } r -= I_ADA;
        { const int g = r >> 3; transpose_item(a.w_pool + g * 16384, 128, 4, 128, (bf16*)(ws + WS_WPOOL) + g * 16384, scr, r & 7, lane, 1.f); }
    }
    bf16* S = (bf16*)(ws + WS_SILU);
    for (int i = gw * 64 + lane; i < NMODP * D; i += NGW * 64) {
        const int row = i >> 10, col = i & 1023; float v = 0.f;
        if (row < NBATCH) v = a.c_prompt[row * D + col]; else if (row < NMOD) v = a.c_sample[(row - NBATCH) * D + col];
        S[i] = (bf16)f2bf(v * sigmoidf_(v));
    }
}

template <int MODE> __device__ __forceinline__ void small_gemm(const bf16* A, const bf16* Bt, int N, int K, int Mtiles, int gw, int NGW, int lane, void* outp, const float* bias) {
    const int fr = lane & 15, fq = lane >> 4;
    const int ntile = Mtiles * (N >> 4);
    for (int tile = gw; tile < ntile; tile += NGW) {
        const int mt = tile % Mtiles, nt = tile / Mtiles;
        const bf16* ap = A + (size_t)(mt * 16 + fr) * K + fq * 8;
        const int brow = (MODE == 1 && nt >= 128) ? (nt + 32) * 16 : nt * 16;
        const bf16* bp = Bt + (size_t)(brow + fr) * K + fq * 8;
        f32x4 acc = (f32x4){0.f, 0.f, 0.f, 0.f};
#pragma unroll 8
        for (int k = 0; k < K; k += 32) { const bf16x8 av = *(const bf16x8*)(ap + k); const bf16x8 bv = *(const bf16x8*)(bp + k); acc = mfma16(av, bv, acc); }
        const int col = nt * 16 + fr;
#pragma unroll
        for (int j = 0; j < 4; ++j) { const int row = mt * 16 + fq * 4 + j; const float v = acc[j];
            if (MODE == 0) { if (row < NMOD) ((float*)outp)[(size_t)row * MODC + col] = v + bias[col]; }
            else if (MODE == 1) ((bf16*)outp)[(size_t)row * NZS + col] = (bf16)f2bf(v);
            else if (MODE == 2) ((float*)outp)[(size_t)row * D + col] = v;
            else if (MODE == 3) { const float r = fmaxf(v, 0.f); ((bf16*)outp)[(size_t)row * FF + col] = (bf16)f2bf(r * r); }
            else ((bf16*)outp)[(size_t)row * D + col] = (bf16)f2bf(v); }
    }
}

__device__ __forceinline__ void phase1a(const Args& a, unsigned char* lds, int gw, int NGW, int lane, int tid) {
    f32x4* wg4 = (f32x4*)lds;
    for (int i = tid; i < 2048; i += 512) { const int k = i >> 1, hf = i & 1; wg4[i] = *(const f32x4*)(a.w_in + (size_t)k * INC + 2048 + hf * 4); }
    __syncthreads();
    const float* MOD = (const float*)(a.ws + WS_MOD); bf16* HN = (bf16*)(a.ws + WS_H); float* GATES = (float*)(a.ws + WS_GATES);
    for (int row = gw; row < MT; row += NGW) {
        const float* xr = row < MP ? a.x_prompt + (size_t)row * D : a.x_sample + (size_t)(row - MP) * D;
        const float* md = MOD + (size_t)mod_row(row) * MODC;
        f32x4 v[4]; float ss = 0.f;
#pragma unroll
        for (int j = 0; j < 4; ++j) { v[j] = *(const f32x4*)(xr + j * 256 + lane * 4); ss += (v[j][0] * v[j][0] + v[j][1] * v[j][1]) + (v[j][2] * v[j][2] + v[j][3] * v[j][3]); }
        const float rstd = rsqrtf(wave_sum(ss) * (1.f / D) + EPS);
        float g0 = 0.f, g1 = 0.f, g2 = 0.f, g3 = 0.f, g4 = 0.f, g5 = 0.f, g6 = 0.f, g7 = 0.f;
#pragma unroll
        for (int j = 0; j < 4; ++j) { const int col = j * 256 + lane * 4;
            const f32x4 gp = *(const f32x4*)(a.g_pre1 + col), sh = *(const f32x4*)(md + col), sc = *(const f32x4*)(md + D + col);
            f32x4 h = v[j] * rstd * gp * (sc + 1.f) + sh;
            u32x2 o; o.x = pk2(h[0], h[1]); o.y = pk2(h[2], h[3]); *(u32x2*)(HN + (size_t)row * D + col) = o;
#pragma unroll
            for (int i = 0; i < 4; ++i) { const f32x4 w0 = wg4[(col + i) * 2], w1 = wg4[(col + i) * 2 + 1]; const float hv = h[i];
                g0 += hv * w0[0]; g1 += hv * w0[1]; g2 += hv * w0[2]; g3 += hv * w0[3]; g4 += hv * w1[0]; g5 += hv * w1[1]; g6 += hv * w1[2]; g7 += hv * w1[3]; } }
        g0 = wave_sum(g0); g1 = wave_sum(g1); g2 = wave_sum(g2); g3 = wave_sum(g3); g4 = wave_sum(g4); g5 = wave_sum(g5); g6 = wave_sum(g6); g7 = wave_sum(g7);
        if (lane == 0) {
            f32x4 ig = (f32x4){g0 + a.b_ig[0], g1 + a.b_ig[1], g2 + a.b_ig[2], g3 + a.b_ig[3]};
            f32x4 fg = (f32x4){g4 + a.b_fg[0], g5 + a.b_fg[1], g6 + a.b_fg[2], g7 + a.b_fg[3]}; f32x4 lf;
#pragma unroll
            for (int i = 0; i < 4; ++i) lf[i] = fminf(fg[i], 0.f) - log1pf(expf(-fabsf(fg[i])));
            *(f32x4*)(GATES + (size_t)row * 8) = ig; *(f32x4*)(GATES + (size_t)row * 8 + 4) = lf;
        }
    }
    __syncthreads();
}

__device__ __forceinline__ float scan_add(float v, int lane) {
#pragma unroll
    for (int o = 1; o < 64; o <<= 1) { const float t = __shfl_up(v, o); if (lane >= o) v += t; }
    return v;
}
__device__ __forceinline__ float scan_max(float v, int lane) {
#pragma unroll
    for (int o = 1; o < 64; o <<= 1) { const float t = __shfl_up(v, o); if (lane >= o) v = fmaxf(v, t); }
    return v;
}
__device__ __forceinline__ bf16x8 as_bf16x8(u32x4 v) { return __builtin_bit_cast(bf16x8, v); }

__device__ __forceinline__ void p2_chunk_job(const Args& a, int job, int lane_) {
    int lane = lane_; asm volatile("" : "+v"(lane));
    const int it = job >> 2, ep = job & 3, bh = it >> 5, c = it & 31, b = bh >> 2, h = bh & 3, r0 = b * SEQ + c * 64;
    const int fr = lane & 15, fq = lane >> 4;
    const float* GATES = (const float*)(a.ws + WS_GATES); const bf16* ZT = (const bf16*)(a.ws + WS_ZT);
    const float lf = GATES[(size_t)(r0 + lane) * 8 + 4 + h], ig = GATES[(size_t)(r0 + lane) * 8 + h];
    u32x4 raw[2][2]; bf16x8 ka[8][2];
#pragma unroll
    for (int ei = 0; ei < 2; ++ei)
#pragma unroll
        for (int ks = 0; ks < 2; ++ks) raw[ei][ks] = *(const u32x4*)(ZT + ztc(512 + h * 128 + (ep * 2 + ei) * 16 + fr, r0 + ks * 32 + fq * 8));
#pragma unroll
    for (int dt = 0; dt < 8; ++dt) { ka[dt][0] = *(const bf16x8*)(ZT + ztc(h * 128 + dt * 16 + fr, r0 + fq * 8)); ka[dt][1] = *(const bf16x8*)(ZT + ztc(h * 128 + dt * 16 + fr, r0 + 32 + fq * 8)); }
    __builtin_amdgcn_sched_barrier(0);
    const float bs = scan_add(lf, lane); const float B = __shfl(bs, 63); const float val = B - bs + ig; const float mloc = wave_max(val); const float wL = __expf(val - mloc);
    if (ep == 0 && lane == 0) { ((float*)(a.ws + WS_CHB))[it] = B; ((float*)(a.ws + WS_CHM))[it] = mloc; }
    float wv[2][8];
#pragma unroll
    for (int ks = 0; ks < 2; ++ks)
#pragma unroll
        for (int jj = 0; jj < 8; ++jj) wv[ks][jj] = __shfl(wL, ks * 32 + fq * 8 + jj);
    bf16x8 vb[2][2], wf[2];
#pragma unroll
    for (int ks = 0; ks < 2; ++ks) { u32x4 w; w.x = pk2(wv[ks][0], wv[ks][1]); w.y = pk2(wv[ks][2], wv[ks][3]); w.z = pk2(wv[ks][4], wv[ks][5]); w.w = pk2(wv[ks][6], wv[ks][7]); wf[ks] = as_bf16x8(w);
#pragma unroll
        for (int ei = 0; ei < 2; ++ei) { u32x4 o;
#pragma unroll
            for (int q = 0; q < 4; ++q) o[q] = pk2(bflo(raw[ei][ks][q]) * wv[ks][2 * q], bfhi(raw[ei][ks][q]) * wv[ks][2 * q + 1]);
            vb[ei][ks] = as_bf16x8(o); } }
    bf16* U = (bf16*)(a.ws + WS_U) + (size_t)it * 16384;
#pragma unroll
    for (int dt = 0; dt < 8; ++dt) {
        const bf16x8 a0 = ka[dt][0], a1 = ka[dt][1];
#pragma unroll
        for (int ei = 0; ei < 2; ++ei) { f32x4 acc = mfma16(a0, vb[ei][0], (f32x4){0.f, 0.f, 0.f, 0.f}); acc = mfma16(a1, vb[ei][1], acc);
            u32x2 o; o.x = pk2(acc[0], acc[1]); o.y = pk2(acc[2], acc[3]);
            *(u32x2*)(U + ((dt * 2 + (fq >> 1)) * 128 + (ep * 2 + ei) * 16 + fr) * 8 + (fq & 1) * 4) = o; }
        if ((dt >> 1) == ep) { f32x4 accn = mfma16(a0, wf[0], (f32x4){0.f, 0.f, 0.f, 0.f}); accn = mfma16(a1, wf[1], accn);
            if (fr == 0) *(f32x4*)((float*)(a.ws + WS_NU) + (size_t)it * 128 + dt * 16 + fq * 4) = accn; }
    }
}

#define POOL_WLOAD() bf16x8 wa[8]; do { _Pragma("unroll") for (int dt = 0; dt < 8; ++dt) wa[dt] = *(const bf16x8*)(WP + wofs + dt * 2048 + ks * 32); } while (0)
#define POOL_MMA_STEP() do { _Pragma("unroll") for (int dt = 0; dt < 8; ++dt) acc[dt] = mfma16(wa[dt], pfk, acc[dt]); } while (0)
#define POOL_STORE(mixrow) do { _Pragma("unroll") for (int dt = 0; dt < 8; ++dt) { const f32x4 sc = *(const f32x4*)(a.pool_scale + gi * 128 + dt * 16 + fq * 4); \
        u32x2 o; o.x = pk2(acc[dt][0] * sc[0], acc[dt][1] * sc[1]); o.y = pk2(acc[dt][2] * sc[2], acc[dt][3] * sc[3]); \
        *(u32x2*)((bf16*)(a.ws + WS_H) + (size_t)(mixrow) * D + 512 + gi * 128 + dt * 16 + fq * 4) = o; } } while (0)

template <int WIN> __device__ __forceinline__ void pool_prompt_body(const Args& a, int b, int t0, int gi, int lane_) {
    int lane = lane_; asm volatile("" : "+v"(lane));
    const int fr = lane & 15, fq = lane >> 4, t = t0 + fr;
    const bf16* Z = (const bf16*)(a.ws + WS_Z); const bf16* WP = (const bf16*)(a.ws + WS_WPOOL) + gi * 16384; const int wofs = fr * 128 + fq * 8;
    const float inv = 1.f / (float)min(t + 1, WIN);
    f32x4 acc[8];
#pragma unroll
    for (int dt = 0; dt < 8; ++dt) acc[dt] = (f32x4){0.f, 0.f, 0.f, 0.f};
#pragma unroll 1
    for (int ks = 0; ks < 4; ++ks) { const int c0 = ks * 32 + fq * 8;
        const bf16* ub = Z + zc(b * SEQ, 1536 + gi * 128 + c0);
        POOL_WLOAD();
        u32x4 w[WIN];
#pragma unroll
        for (int jj = 0; jj < WIN; ++jj) { const int tj = max(t - jj, 0); w[jj] = *(const u32x4*)(ub + (size_t)tj * 8); }
        __builtin_amdgcn_sched_barrier(0);
        const u32x4 u0 = w[0];
        float s0 = bflo(u0[0]), s1 = bfhi(u0[0]), s2 = bflo(u0[1]), s3 = bfhi(u0[1]), s4 = bflo(u0[2]), s5 = bfhi(u0[2]), s6 = bflo(u0[3]), s7 = bfhi(u0[3]);
#pragma unroll
        for (int jj = 1; jj < WIN; ++jj) { const float vld = (t - jj >= 0) ? 1.f : 0.f;
            s0 += bflo(w[jj][0]) * vld; s1 += bfhi(w[jj][0]) * vld; s2 += bflo(w[jj][1]) * vld; s3 += bfhi(w[jj][1]) * vld;
            s4 += bflo(w[jj][2]) * vld; s5 += bfhi(w[jj][2]) * vld; s6 += bflo(w[jj][3]) * vld; s7 += bfhi(w[jj][3]) * vld; }
        u32x4 o; o.x = pk2(s0 * inv - bflo(u0[0]), s1 * inv - bfhi(u0[0])); o.y = pk2(s2 * inv - bflo(u0[1]), s3 * inv - bfhi(u0[1]));
        o.z = pk2(s4 * inv - bflo(u0[2]), s5 * inv - bfhi(u0[2])); o.w = pk2(s6 * inv - bflo(u0[3]), s7 * inv - bfhi(u0[3]));
        const bf16x8 pfk = as_bf16x8(o);
        if (t0 == SEQ - 16 && fr >= 1) { float* pp = a.out + O_PP + (size_t)(b * 15 + fr - 1) * 512 + gi * 128 + c0;
            *(f32x4*)pp = (f32x4){bflo(u0[0]), bfhi(u0[0]), bflo(u0[1]), bfhi(u0[1])}; *(f32x4*)(pp + 4) = (f32x4){bflo(u0[2]), bfhi(u0[2]), bflo(u0[3]), bfhi(u0[3])}; }
        POOL_MMA_STEP();
    }
    POOL_STORE(b * SEQ + t);
}
__device__ __forceinline__ void p2_pool_prompt_job(const Args& a, int job, int lane) {
    const int r = job >> 11, q = job & 2047, gi = r ? 3 - (q & 3) : (q & 3), bt = (q >> 2) + r * 512, b = bt >> 7, t0 = (bt & 127) * 16;
    if (gi == 0) pool_prompt_body<2>(a, b, t0, 0, lane); else if (gi == 1) pool_prompt_body<4>(a, b, t0, 1, lane);
    else if (gi == 2) pool_prompt_body<8>(a, b, t0, 2, lane); else pool_prompt_body<16>(a, b, t0, 3, lane);
}

template <int WIN> __device__ __forceinline__ void pool_sample_body(const Args& a, int tile, int gi, int lane_) {
    int lane = lane_; asm volatile("" : "+v"(lane));
    const int fr = lane & 15, fq = lane >> 4, bsi = tile * 16 + fr;
    const bf16* ZS = (const bf16*)(a.ws + WS_ZS); const bf16* WP = (const bf16*)(a.ws + WS_WPOOL) + gi * 16384; const int wofs = fr * 128 + fq * 8;
    const float inv = 1.f / (float)WIN;
    f32x4 acc[8];
#pragma unroll
    for (int dt = 0; dt < 8; ++dt) acc[dt] = (f32x4){0.f, 0.f, 0.f, 0.f};
#pragma unroll 1
    for (int ks = 0; ks < 4; ++ks) { const int c0 = ks * 32 + fq * 8;
        POOL_WLOAD();
        const u32x4 u0 = *(const u32x4*)(ZS + (size_t)bsi * NZS + 1536 + gi * 128 + c0);
        f32x4 p0[WIN], p1[WIN];
#pragma unroll
        for (int jj = 1; jj < WIN; ++jj) { const float* sp = a.state_pool + (size_t)(bsi * 15 + 15 - jj) * 512 + gi * 128 + c0; p0[jj] = *(const f32x4*)sp; p1[jj] = *(const f32x4*)(sp + 4); }
        __builtin_amdgcn_sched_barrier(0);
        float s0 = bflo(u0[0]), s1 = bfhi(u0[0]), s2 = bflo(u0[1]), s3 = bfhi(u0[1]), s4 = bflo(u0[2]), s5 = bfhi(u0[2]), s6 = bflo(u0[3]), s7 = bfhi(u0[3]);
#pragma unroll
        for (int jj = 1; jj < WIN; ++jj) { s0 += p0[jj][0]; s1 += p0[jj][1]; s2 += p0[jj][2]; s3 += p0[jj][3]; s4 += p1[jj][0]; s5 += p1[jj][1]; s6 += p1[jj][2]; s7 += p1[jj][3]; }
        u32x4 o; o.x = pk2(s0 * inv - bflo(u0[0]), s1 * inv - bfhi(u0[0])); o.y = pk2(s2 * inv - bflo(u0[1]), s3 * inv - bfhi(u0[1]));
        o.z = pk2(s4 * inv - bflo(u0[2]), s5 * inv - bfhi(u0[2])); o.w = pk2(s6 * inv - bflo(u0[3]), s7 * inv - bfhi(u0[3]));
        const bf16x8 pfk = as_bf16x8(o);
        POOL_MMA_STEP();
    }
    POOL_STORE(MP + bsi);
}
__device__ __forceinline__ void p2_pool_sample_job(const Args& a, int job, int lane) {
    const int gi = job & 3, tile = job >> 2;
    if (gi == 0) pool_sample_body<2>(a, tile, 0, lane); else if (gi == 1) pool_sample_body<4>(a, tile, 1, lane);
    else if (gi == 2) pool_sample_body<8>(a, tile, 2, lane); else pool_sample_body<16>(a, tile, 3, lane);
}

__device__ __forceinline__ void p2_sample_item(const Args& a, unsigned char* lds, int it2, int tid, int lane, int wave) {
    const int bs = it2 >> 2, h = it2 & 3, r = MP + bs, sh = bs * 4 + h;
    const bf16* ZS = (const bf16*)(a.ws + WS_ZS) + (size_t)bs * NZS; const float* GATES = (const float*)(a.ws + WS_GATES); bf16* MIX = (bf16*)(a.ws + WS_H);
    float* qs = (float*)lds; float* ks = qs + 128; float* vs = qs + 256; float* scal = qs + 384; float* hs = qs + 512; float* red = qs + 1024;
    if (tid < 128) { qs[tid] = bf2f(ZS[h * 128 + tid]); ks[tid] = bf2f(ZS[512 + h * 128 + tid]); vs[tid] = bf2f(ZS[2048 + h * 128 + tid]); }
    __syncthreads();
    if (wave == 0) {
        const float n0a = a.state_n[(size_t)sh * 128 + lane], n0b = a.state_n[(size_t)sh * 128 + 64 + lane];
        const float qk = wave_sum(qs[lane] * ks[lane] + qs[lane + 64] * ks[lane + 64]);
        const float qn = wave_sum(qs[lane] * n0a + qs[lane + 64] * n0b);
        const float ig = GATES[(size_t)r * 8 + h], lf = GATES[(size_t)r * 8 + 4 + h], m0 = a.state_m[sh];
        const float g = lf + m0, m = fmaxf(g, ig), w = __expf(ig - m), al = __expf(g - m);
        const float s = qk * w, den = al * qn + s, dn = fmaxf(fabsf(den), __expf(-m));
        if (lane == 0) { scal[0] = al; scal[1] = w; scal[2] = s; scal[3] = dn; a.out[O_MS + sh] = m; }
        a.out[O_NS + (size_t)sh * 128 + lane] = al * n0a + w * ks[lane]; a.out[O_NS + (size_t)sh * 128 + 64 + lane] = al * n0b + w * ks[lane + 64];
    }
    __syncthreads();
    {
        const int e4 = (tid & 31) * 4, dg = tid >> 5; const float al = scal[0], w = scal[1];
        const f32x4 v4 = *(const f32x4*)(vs + e4); f32x4 part = (f32x4){0.f, 0.f, 0.f, 0.f};
        const float* C0 = a.state_C + (size_t)sh * 16384; float* C1 = a.out + O_CS + (size_t)sh * 16384;
        f32x4 c0[8];
#pragma unroll
        for (int dd = 0; dd < 8; ++dd) c0[dd] = *(const f32x4*)(C0 + (dg * 8 + dd) * 128 + e4);
#pragma unroll
        for (int dd = 0; dd < 8; ++dd) { const int d = dg * 8 + dd; part += c0[dd] * qs[d]; *(f32x4*)(C1 + d * 128 + e4) = c0[dd] * al + v4 * (w * ks[d]); }
        *(f32x4*)(red + dg * 128 + e4) = part;
    }
    __syncthreads();
    if (tid < 128) { float qc = 0.f;
#pragma unroll
        for (int dg = 0; dg < 16; ++dg) qc += red[dg * 128 + tid];
        hs[tid] = (scal[0] * qc + scal[2] * vs[tid]) / scal[3]; }
    __syncthreads();
    if (wave == 0) {
        const float h0 = hs[lane], h1 = hs[lane + 64];
        const float rstd = rsqrtf(wave_sum(h0 * h0 + h1 * h1) * (1.f / 128.f) + EPS);
        const float o0 = bf2f(ZS[1024 + h * 128 + lane]), o1 = bf2f(ZS[1024 + h * 128 + 64 + lane]);
        MIX[(size_t)r * D + h * 128 + lane] = (bf16)f2bf(h0 * rstd * a.g_head[lane] * sigmoidf_(o0));
        MIX[(size_t)r * D + h * 128 + 64 + lane] = (bf16)f2bf(h1 * rstd * a.g_head[lane + 64] * sigmoidf_(o1));
    }
    for (int idx = tid; idx < 15 * 128; idx += 512) { const int i = idx >> 7, cc = h * 128 + (idx & 127);
        a.out[O_PS + (size_t)(bs * 15 + i) * 512 + cc] = i < 14 ? a.state_pool[(size_t)(bs * 15 + i + 1) * 512 + cc] : bf2f(ZS[1536 + cc]); }
    __syncthreads();
}

#ifndef PROBE_P2SUB
#define PROBE_P2SUB 0
#endif
__device__ __forceinline__ void phase2(const Args& a, unsigned char* lds, int gw, int NGW, int tid, int lane, int wave) {
    for (int rp = 0; rp < 1 + ((PROBE_P2SUB & 1) ? 2 : 0); ++rp)
    for (int it = blockIdx.x; it < 512; it += gridDim.x) p2_sample_item(a, lds, it, tid, lane, wave);
    for (int rp = 0; rp < 1 + ((PROBE_P2SUB & 2) ? 2 : 0); ++rp)
    for (int job = gw; job < 4096; job += NGW) p2_chunk_job(a, job, lane);
    for (int rp = 0; rp < 1 + ((PROBE_P2SUB & 4) ? 2 : 0); ++rp)
    for (int job = gw; job < 4096 + 32; job += NGW) { if (job < 4096) p2_pool_prompt_job(a, job, lane); else p2_pool_sample_job(a, job - 4096, lane); }
}

__device__ __forceinline__ void phase3(const Args& a, int tid) {
    const bf16* U = (const bf16*)(a.ws + WS_U); bf16* CST = (bf16*)(a.ws + WS_CST);
    const float* CHB = (const float*)(a.ws + WS_CHB); const float* CHM = (const float*)(a.ws + WS_CHM); float* MST = (float*)(a.ws + WS_MST);
    const float* NU = (const float*)(a.ws + WS_NU); float* NST = (float*)(a.ws + WS_NST);
    for (int idx = blockIdx.x * 512 + tid; idx < 32 * 4096; idx += gridDim.x * 512) {
        const int bh = idx >> 12, rem = idx & 4095, e = (rem >> 1) & 127, d4 = (rem >> 8) * 8 + (rem & 1) * 4;
        f32x4 C = (f32x4){0.f, 0.f, 0.f, 0.f}; float m = 0.f, nacc = 0.f;
#pragma unroll 8
        for (int c = 0; c < NCH; ++c) { const int it = bh * 32 + c;
            const u32x2 uw = *(const u32x2*)(U + (size_t)it * 16384 + rem * 4); const f32x4 u = (f32x4){bflo(uw.x), bfhi(uw.x), bflo(uw.y), bfhi(uw.y)};
            u32x2 o; o.x = pk2(C[0], C[1]); o.y = pk2(C[2], C[3]); *(u32x2*)(CST + (size_t)it * 16384 + rem * 4) = o;
            float nu = 0.f;
            if (rem < 128) { NST[(size_t)it * 128 + rem] = nacc; nu = NU[(size_t)it * 128 + rem]; }
            if (rem == 0) MST[it] = m;
            const float B = CHB[it], ml = CHM[it], m2 = fmaxf(B + m, ml), al = __expf(B + m - m2), be = __expf(ml - m2);
            C = C * al + u * be; nacc = al * nacc + be * nu; m = m2; }
        float* CP = a.out + O_CP + (size_t)bh * 16384;
#pragma unroll
        for (int i = 0; i < 4; ++i) CP[(d4 + i) * 128 + e] = C[i];
        if (rem < 128) a.out[O_NP + (size_t)bh * 128 + rem] = nacc;
        if (rem == 0) a.out[O_MP + bh] = m;
    }
}

__device__ __forceinline__ void p4_job(const Args& a, int job, int lane_) {
    int lane = lane_; asm volatile("" : "+v"(lane));
    const int it = job >> 2, tt = job & 3, bh = it >> 5, c = it & 31, b = bh >> 2, h = bh & 3, r0 = b * SEQ + c * 64;
    const int fr = lane & 15, fq = lane >> 4, tl = tt * 16 + fr;
    const bf16* Z = (const bf16*)(a.ws + WS_Z); const float* GATES = (const float*)(a.ws + WS_GATES); bf16* MIX = (bf16*)(a.ws + WS_H);
    const bf16* CST = (const bf16*)(a.ws + WS_CST) + (size_t)it * 16384; const bf16* ZT = (const bf16*)(a.ws + WS_ZT);
    const float lf = GATES[(size_t)(r0 + lane) * 8 + 4 + h], ig = GATES[(size_t)(r0 + lane) * 8 + h];
    const float m0 = ((const float*)(a.ws + WS_MST))[it];
    bf16x8 qf[4], kf[4][4];
#pragma unroll
    for (int ks = 0; ks < 4; ++ks) qf[ks] = *(const bf16x8*)(Z + zc(r0 + tl, h * 128 + ks * 32 + fq * 8));
#pragma unroll
    for (int st = 0; st < 4; ++st)
#pragma unroll
        for (int ks = 0; ks < 4; ++ks) kf[st][ks] = *(const bf16x8*)(Z + zc(r0 + st * 16 + fr, 512 + h * 128 + ks * 32 + fq * 8));
    f32x4 n0v[4][2];
    { const float* n0 = (const float*)(a.ws + WS_NST) + (size_t)it * 128;
#pragma unroll
        for (int ks = 0; ks < 4; ++ks) { n0v[ks][0] = *(const f32x4*)(n0 + ks * 32 + fq * 8); n0v[ks][1] = *(const f32x4*)(n0 + ks * 32 + fq * 8 + 4); } }
    __builtin_amdgcn_sched_barrier(0);
    const float bs = scan_add(lf, lane); const float cs = ig - bs; const float pm = scan_max(cs, lane); const float mt = bs + fmaxf(m0, pm); const float at = __expf(bs + m0 - mt);
    const float bm_t = __shfl(bs - mt, tl), a_t = __shfl(at, tl), em_t = __expf(-__shfl(mt, tl));
    float sv[4][4]; float ssum = 0.f;
#pragma unroll
    for (int st = 0; st < 4; ++st) { f32x4 acc = (f32x4){0.f, 0.f, 0.f, 0.f};
#pragma unroll
        for (int ks = 0; ks < 4; ++ks) acc = mfma16(kf[st][ks], qf[ks], acc);
#pragma unroll
        for (int j = 0; j < 4; ++j) { const int s = st * 16 + fq * 4 + j; const float cj = __shfl(cs, s);
            const float w = (s <= tl) ? __expf(bm_t + cj) : 0.f; sv[st][j] = acc[j] * w; ssum += sv[st][j]; } }
    ssum += __shfl_xor(ssum, 16); ssum += __shfl_xor(ssum, 32);
    bf16x8 sf[2];
#pragma unroll
    for (int kp = 0; kp < 2; ++kp) { u32x4 w; w.x = pk2(sv[2 * kp][0], sv[2 * kp][1]); w.y = pk2(sv[2 * kp][2], sv[2 * kp][3]); w.z = pk2(sv[2 * kp + 1][0], sv[2 * kp + 1][1]); w.w = pk2(sv[2 * kp + 1][2], sv[2 * kp + 1][3]); sf[kp] = as_bf16x8(w); }
    f32x4 accn = (f32x4){0.f, 0.f, 0.f, 0.f};
#pragma unroll
    for (int ks = 0; ks < 4; ++ks) { const f32x4 x0 = n0v[ks][0], x1 = n0v[ks][1];
        u32x4 w; w.x = pk2(x0[0], x0[1]); w.y = pk2(x0[2], x0[3]); w.z = pk2(x1[0], x1[1]); w.w = pk2(x1[2], x1[3]); accn = mfma16(as_bf16x8(w), qf[ks], accn); }
    const float inv = 1.f / fmaxf(fabsf(a_t * accn[0] + ssum), em_t);
    f32x4 hT[8]; float ss = 0.f;
    bf16x8 cb[4][4]; u32x2 vlo[4][2], vhi[4][2];
#define P4_LOAD(buf, et) do { _Pragma("unroll") for (int ks = 0; ks < 4; ++ks) cb[buf][ks] = *(const bf16x8*)(CST + ((ks * 4 + fq) * 128 + (et) * 16 + fr) * 8); \
        _Pragma("unroll") for (int kp = 0; kp < 2; ++kp) { const bf16* vp = ZT + ztc(512 + h * 128 + (et) * 16 + fr, r0 + kp * 32 + fq * 4); vlo[buf][kp] = *(const u32x2*)vp; vhi[buf][kp] = *(const u32x2*)(vp + (size_t)2 * ZTR * 8); } } while (0)
#pragma unroll
    for (int eg = 0; eg < 2; ++eg) {
#pragma unroll
        for (int i = 0; i < 4; ++i) P4_LOAD(i, eg * 4 + i);
        __builtin_amdgcn_sched_barrier(0);
#pragma unroll
        for (int i = 0; i < 4; ++i) { const int et = eg * 4 + i;
            f32x4 acc1 = (f32x4){0.f, 0.f, 0.f, 0.f}, acc2 = (f32x4){0.f, 0.f, 0.f, 0.f};
#pragma unroll
            for (int ks = 0; ks < 4; ++ks) acc1 = mfma16(cb[i][ks], qf[ks], acc1);
#pragma unroll
            for (int kp = 0; kp < 2; ++kp) { u32x4 w; w.x = vlo[i][kp].x; w.y = vlo[i][kp].y; w.z = vhi[i][kp].x; w.w = vhi[i][kp].y; acc2 = mfma16(as_bf16x8(w), sf[kp], acc2); }
#pragma unroll
            for (int j = 0; j < 4; ++j) { const float hv = (a_t * acc1[j] + acc2[j]) * inv; hT[et][j] = hv; ss += hv * hv; } }
        __builtin_amdgcn_sched_barrier(0);
    }
#undef P4_LOAD
    ss += __shfl_xor(ss, 16); ss += __shfl_xor(ss, 32);
    const float rstd = rsqrtf(ss * (1.f / 128.f) + EPS);
    bf16* mrow = MIX + (size_t)(r0 + tl) * D + h * 128;
    u32x2 ow[8];
#pragma unroll
    for (int et = 0; et < 8; ++et) ow[et] = *(const u32x2*)(Z + zc(r0 + tl, 1024 + h * 128 + et * 16 + fq * 4));
    __builtin_amdgcn_sched_barrier(0);
#pragma unroll
    for (int et = 0; et < 8; ++et) { const f32x4 gh = *(const f32x4*)(a.g_head + et * 16 + fq * 4);
        u32x2 o; o.x = pk2(hT[et][0] * rstd * gh[0] * sigmoidf_(bflo(ow[et].x)), hT[et][1] * rstd * gh[1] * sigmoidf_(bfhi(ow[et].x)));
        o.y = pk2(hT[et][2] * rstd * gh[2] * sigmoidf_(bflo(ow[et].y)), hT[et][3] * rstd * gh[3] * sigmoidf_(bfhi(ow[et].y)));
        *(u32x2*)(mrow + et * 16 + fq * 4) = o; }
}

__device__ __forceinline__ void phase6(const Args& a, int gw, int NGW, int lane) {
    const float* MOD = (const float*)(a.ws + WS_MOD); const float* T1 = (const float*)(a.ws + WS_T1); bf16* HN = (bf16*)(a.ws + WS_H);
    for (int row = gw; row < MT; row += NGW) {
        const float* xr = row < MP ? a.x_prompt + (size_t)row * D : a.x_sample + (size_t)(row - MP) * D;
        const float* md = MOD + (size_t)mod_row(row) * MODC; const float* tr = T1 + (size_t)row * D; float* orow = a.out + (size_t)row * D;
        f32x4 t[4], x1[4]; float ss = 0.f;
#pragma unroll
        for (int j = 0; j < 4; ++j) { t[j] = *(const f32x4*)(tr + j * 256 + lane * 4); ss += (t[j][0] * t[j][0] + t[j][1] * t[j][1]) + (t[j][2] * t[j][2] + t[j][3] * t[j][3]); }
        const float rstd = rsqrtf(wave_sum(ss) * (1.f / D) + EPS); float ss2 = 0.f;
#pragma unroll
        for (int j = 0; j < 4; ++j) { const int col = j * 256 + lane * 4;
            const f32x4 xv = *(const f32x4*)(xr + col), gp = *(const f32x4*)(a.g_post1 + col), ga = *(const f32x4*)(md + 2 * D + col);
            x1[j] = xv + ga * (t[j] * rstd * gp); *(f32x4*)(orow + col) = x1[j];
            ss2 += (x1[j][0] * x1[j][0] + x1[j][1] * x1[j][1]) + (x1[j][2] * x1[j][2] + x1[j][3] * x1[j][3]); }
        const float rstd2 = rsqrtf(wave_sum(ss2) * (1.f / D) + EPS);
#pragma unroll
        for (int j = 0; j < 4; ++j) { const int col = j * 256 + lane * 4;
            const f32x4 gp = *(const f32x4*)(a.g_pre2 + col), sh = *(const f32x4*)(md + 3 * D + col), sc = *(const f32x4*)(md + 4 * D + col);
            const f32x4 h = x1[j] * rstd2 * gp * (sc + 1.f) + sh;
            u32x2 o; o.x = pk2(h[0], h[1]); o.y = pk2(h[2], h[3]); *(u32x2*)(HN + (size_t)row * D + col) = o; }
    }
}

__device__ __forceinline__ void phase9(const Args& a, int gw, int NGW, int lane) {
    const float* MOD = (const float*)(a.ws + WS_MOD); const bf16* T2 = (const bf16*)(a.ws + WS_T2);
    for (int row = gw; row < MT; row += NGW) {
        const float* md = MOD + (size_t)mod_row(row) * MODC; const bf16* tr = T2 + (size_t)row * D; float* orow = a.out + (size_t)row * D;
        f32x4 t[4]; float ss = 0.f;
#pragma unroll
        for (int j = 0; j < 4; ++j) { const u32x2 w = *(const u32x2*)(tr + j * 256 + lane * 4); t[j] = (f32x4){bflo(w.x), bfhi(w.x), bflo(w.y), bfhi(w.y)};
            ss += (t[j][0] * t[j][0] + t[j][1] * t[j][1]) + (t[j][2] * t[j][2] + t[j][3] * t[j][3]); }
        const float rstd = rsqrtf(wave_sum(ss) * (1.f / D) + EPS);
#pragma unroll
        for (int j = 0; j < 4; ++j) { const int col = j * 256 + lane * 4;
            const f32x4 xv = *(const f32x4*)(orow + col), gp = *(const f32x4*)(a.g_post2 + col), ga = *(const f32x4*)(md + 5 * D + col);
            *(f32x4*)(orow + col) = xv + ga * (t[j] * rstd * gp); }
    }
}

#define LAS __attribute__((address_space(3)))
#define XB_TMO      128
#define XB_XCNT(j)  (256  + 64 * (j))
#define XB_XSUB(j)  (1280 + 64 * (j))
#define XB_XGEN(j)  (2304 + 64 * (j))
#define XB_TOP      3328
#define XB_TOPGEN   3392
#define XCD_BAR_WORDS 3456
#define XB_SPIN_CAP (1u << 18)

__device__ __forceinline__ unsigned xb_ld(unsigned* p)              { return __hip_atomic_load(p, __ATOMIC_RELAXED, __HIP_MEMORY_SCOPE_AGENT); }
__device__ __forceinline__ unsigned xb_add(unsigned* p, unsigned v) { return __hip_atomic_fetch_add(p, v, __ATOMIC_RELAXED, __HIP_MEMORY_SCOPE_AGENT); }
__device__ __forceinline__ unsigned xb_xcc_id() { return (unsigned)__builtin_amdgcn_s_getreg((3 << 11) | 20) & 0xFu; }
#define XB_SPIN(cond, bar) do { unsigned _sp = 0; while (cond) { __builtin_amdgcn_s_sleep(1); \
    if ((++_sp & 255u) == 0u) { if (xb_ld(&(bar)[XB_TMO])) break; if (_sp > XB_SPIN_CAP) { atomicAdd(&(bar)[XB_TMO], 1u); break; } } } } while (0)

struct XcdBarrier {
    unsigned* bar; unsigned x;
    volatile LAS unsigned* st;
};

__device__ __forceinline__ XcdBarrier xcd_barrier_post(unsigned* bar, volatile LAS unsigned* st) {
    XcdBarrier b; b.bar = bar; b.x = xb_xcc_id(); b.st = st;
    if (threadIdx.x == 0) (void)xb_add(&bar[XB_XCNT(b.x)], 1u);
    return b;
}
__device__ __forceinline__ void xcd_barrier_complete(unsigned* bar, unsigned x, unsigned& nloc, unsigned& nx) {
    const unsigned G = gridDim.x * gridDim.y * gridDim.z;
    unsigned sum, cnt, mine, sp = 0u;
    for (;;) {
        sum = 0u; cnt = 0u; mine = 0u;
#pragma unroll
        for (unsigned j = 0; j < 16; ++j) { const unsigned c = xb_ld(&bar[XB_XCNT(j)]); sum += c; cnt += (c > 0u) ? 1u : 0u; mine = (j == x) ? c : mine; }
        if (sum == G) break;
        __builtin_amdgcn_s_sleep(1);
        if ((++sp & 255u) == 0u) { if (xb_ld(&bar[XB_TMO])) break; if (sp > XB_SPIN_CAP) { atomicAdd(&bar[XB_TMO], 1u); break; } }
    }
    nloc = mine > 0u ? mine : 1u; nx = cnt > 0u ? cnt : 1u;
}

__device__ __forceinline__ void xcd_barrier(const XcdBarrier& b) {
    asm volatile("s_waitcnt vmcnt(0)" ::: "memory");
    __syncthreads();
    if (threadIdx.x == 0) {
        unsigned* bar = b.bar;
        __builtin_amdgcn_s_waitcnt(0);
        unsigned nloc = b.st[0], nx = b.st[1];
        if (nloc == 0u) { xcd_barrier_complete(bar, b.x, nloc, nx); b.st[0] = nloc; b.st[1] = nx; }
        const unsigned old = xb_add(&bar[XB_XSUB(b.x)], 1u);
        const unsigned gen = old / nloc;
        if (old + 1u == (gen + 1u) * nloc) {
            __builtin_amdgcn_fence(__ATOMIC_RELEASE, "agent");
            asm volatile("s_waitcnt vmcnt(0)" ::: "memory");
            const unsigned og = xb_add(&bar[XB_TOP], 1u);
            const unsigned tg = og / nx;
            if (og + 1u == (tg + 1u) * nx) xb_add(&bar[XB_TOPGEN], 1u);
            else XB_SPIN(xb_ld(&bar[XB_TOPGEN]) == tg, bar);
            __builtin_amdgcn_fence(__ATOMIC_ACQUIRE, "agent");
            xb_add(&bar[XB_XGEN(b.x)], 1u);
            asm volatile("s_waitcnt vmcnt(0)" ::: "memory");
        } else {
            XB_SPIN(xb_ld(&bar[XB_XGEN(b.x)]) == gen, bar);
            __builtin_amdgcn_fence(__ATOMIC_ACQUIRE, "agent");
            asm volatile("s_waitcnt vmcnt(0)" ::: "memory");
        }
    }
    __syncthreads();
}

__global__ void __launch_bounds__(NWAVES * 64, 2) mk_fwd(Args a) {
    extern __shared__ __attribute__((aligned(16))) unsigned char lds[];
    cg::grid_group grid = cg::this_grid();
    const int tid = threadIdx.x, lane = tid & 63, wave = __builtin_amdgcn_readfirstlane(tid >> 6);
    const int G = gridDim.x, gw = blockIdx.x * NWAVES + wave, NGW = G * NWAVES;
    const int gwr = (G - 1 - (int)blockIdx.x) * NWAVES + wave;
    PG8_LAS unsigned char* ldsl = (PG8_LAS unsigned char*)lds;
    unsigned char* ws = a.ws;
    const int lo = a.ph_lo, hi = a.ph_hi;
    if (lo > 1000) grid.sync();
    if (tid < 64) ((unsigned*)(lds + 131072))[tid] = 0u;
    __syncthreads();
    XcdBarrier bar = xcd_barrier_post((unsigned*)ws + CW_BAR, (volatile LAS unsigned*)(lds + 131072) + 8);
#define IN(k) (lo <= (k) && (k) < hi)
#define GSYNC() xcd_barrier(bar)
#define SEAM(k) do { if (IN(k) && IN((k) + 1)) GSYNC(); } while (0)
#ifndef PROBE_MASK
#define PROBE_MASK 0
#endif
#ifndef PROBE_SYNCS
#define PROBE_SYNCS 0
#endif
#define REPS(k) (((PROBE_MASK >> (k)) & 1) ? 2 : 0)
#define PRE(k) for (int rep_ = 0; rep_ < REPS(k); ++rep_)
    for (int i_ = 0; i_ < PROBE_SYNCS; ++i_) GSYNC();

    PRE(0) {
        if (IN(0)) phase0(a, lds, gw, NGW, lane, wave);
        GSYNC(); }
    if (IN(0)) phase0(a, lds, gw, NGW, lane, wave);
    SEAM(0);
    PRE(1) {
        if (IN(1)) small_gemm<0>((const bf16*)(ws + WS_SILU), (const bf16*)(ws + WS_WADA), MODC, D, NMODP / 16, gw, NGW, lane, ws + WS_MOD, a.b_ada);
        GSYNC(); }
    if (IN(1)) small_gemm<0>((const bf16*)(ws + WS_SILU), (const bf16*)(ws + WS_WADA), MODC, D, NMODP / 16, gw, NGW, lane, ws + WS_MOD, a.b_ada);
    SEAM(1);
    PRE(2) {
        if (IN(2)) phase1a(a, lds, gw, NGW, lane, tid);
        GSYNC(); }
    if (IN(2)) phase1a(a, lds, gw, NGW, lane, tid);
    SEAM(2);
    PRE(3) {
        if (IN(3)) {
            { pg8::Gemm g{(const bf16*)(ws + WS_H), (const bf16*)(ws + WS_WIN), MP, NZ, D}; pg8::StaticOrder S; S.init(MP, NZ, G, (int)blockIdx.x);
              pg8::EpiB16CM E{(bf16*)(ws + WS_Z), ZR};
              pg8::gemm_phase<pg8::EpiB16CM, pg8::StaticOrder, true, true>(ldsl, g, S, E); }
            { pg8::Gemm g{(const bf16*)(ws + WS_WIN) + (size_t)2048 * D, (const bf16*)(ws + WS_H), 1024, MP, D}; pg8::StaticOrder S; S.init(1024, MP, G, (int)blockIdx.x);
              pg8::EpiB16CM E{(bf16*)(ws + WS_ZT), ZTR};
              pg8::gemm_phase<pg8::EpiB16CM, pg8::StaticOrder, false, true>(ldsl, g, S, E); }
            small_gemm<1>((const bf16*)(ws + WS_H) + (size_t)MP * D, (const bf16*)(ws + WS_WIN), NZS, D, MS / 16, gw, NGW, lane, ws + WS_ZS, nullptr);
        }
        GSYNC(); }
    if (IN(3)) {
        { pg8::Gemm g{(const bf16*)(ws + WS_H), (const bf16*)(ws + WS_WIN), MP, NZ, D}; pg8::StaticOrder S; S.init(MP, NZ, G, (int)blockIdx.x);
          pg8::EpiB16CM E{(bf16*)(ws + WS_Z), ZR};
          pg8::gemm_phase<pg8::EpiB16CM, pg8::StaticOrder, true, true>(ldsl, g, S, E); }
        { pg8::Gemm g{(const bf16*)(ws + WS_WIN) + (size_t)2048 * D, (const bf16*)(ws + WS_H), 1024, MP, D}; pg8::StaticOrder S; S.init(1024, MP, G, (int)blockIdx.x);
          pg8::EpiB16CM E{(bf16*)(ws + WS_ZT), ZTR};
          pg8::gemm_phase<pg8::EpiB16CM, pg8::StaticOrder, false, true>(ldsl, g, S, E); }
        small_gemm<1>((const bf16*)(ws + WS_H) + (size_t)MP * D, (const bf16*)(ws + WS_WIN), NZS, D, MS / 16, gw, NGW, lane, ws + WS_ZS, nullptr);
    }
    SEAM(3);
    PRE(4) {
        if (IN(4)) phase2(a, lds, gw, NGW, tid, lane, wave);
        GSYNC(); }
    if (IN(4)) phase2(a, lds, gw, NGW, tid, lane, wave);
    SEAM(4);
    PRE(5) {
        if (IN(5)) phase3(a, tid);
        GSYNC(); }
    if (IN(5)) phase3(a, tid);
    SEAM(5);
    PRE(6) {
        if (IN(6)) { for (int job = gw; job < 4096; job += NGW) p4_job(a, job, lane); }
        GSYNC(); }
    if (IN(6)) { for (int job = gw; job < 4096; job += NGW) p4_job(a, job, lane); }
    SEAM(6);
    PRE(7) {
        if (IN(7)) {
            pg8::Gemm g{(const bf16*)(ws + WS_H), (const bf16*)(ws + WS_WOUT), MP, D, D}; pg8::StaticOrder S; S.init(MP, D, G, (int)blockIdx.x);
            pg8::EpiF32 E{(float*)(ws + WS_T1), D};
            pg8::gemm_phase<pg8::EpiF32, pg8::StaticOrder, false, true>(ldsl, g, S, E);
            small_gemm<2>((const bf16*)(ws + WS_H) + (size_t)MP * D, (const bf16*)(ws + WS_WOUT), D, D, MS / 16, gw, NGW, lane, (float*)(ws + WS_T1) + (size_t)MP * D, nullptr);
        }
        GSYNC(); }
    if (IN(7)) {
        pg8::Gemm g{(const bf16*)(ws + WS_H), (const bf16*)(ws + WS_WOUT), MP, D, D}; pg8::StaticOrder S; S.init(MP, D, G, (int)blockIdx.x);
        pg8::EpiF32 E{(float*)(ws + WS_T1), D};
        pg8::gemm_phase<pg8::EpiF32, pg8::StaticOrder, false, true>(ldsl, g, S, E);
        small_gemm<2>((const bf16*)(ws + WS_H) + (size_t)MP * D, (const bf16*)(ws + WS_WOUT), D, D, MS / 16, gw, NGW, lane, (float*)(ws + WS_T1) + (size_t)MP * D, nullptr);
    }
    SEAM(7);
    PRE(8) {
        if (IN(8)) phase6(a, gw, NGW, lane);
        GSYNC(); }
    if (IN(8)) phase6(a, gw, NGW, lane);
    SEAM(8);
    PRE(9) {
        if (IN(9)) {
            pg8::Gemm g{(const bf16*)(ws + WS_H), (const bf16*)(ws + WS_WUP), MP, FF, D}; pg8::StaticOrder S; S.init(MP, FF, G, (int)blockIdx.x);
            pg8::EpiB16<1> E{(bf16*)(ws + WS_F), FF};
            pg8::gemm_phase<pg8::EpiB16<1>, pg8::StaticOrder, true, true>(ldsl, g, S, E);
            small_gemm<3>((const bf16*)(ws + WS_H) + (size_t)MP * D, (const bf16*)(ws + WS_WUP), FF, D, MS / 16, gw, NGW, lane, (bf16*)(ws + WS_F) + (size_t)MP * FF, nullptr);
        }
        GSYNC(); }
    if (IN(9)) {
        pg8::Gemm g{(const bf16*)(ws + WS_H), (const bf16*)(ws + WS_WUP), MP, FF, D}; pg8::StaticOrder S; S.init(MP, FF, G, (int)blockIdx.x);
        pg8::EpiB16<1> E{(bf16*)(ws + WS_F), FF};
        pg8::gemm_phase<pg8::EpiB16<1>, pg8::StaticOrder, true, true>(ldsl, g, S, E);
        small_gemm<3>((const bf16*)(ws + WS_H) + (size_t)MP * D, (const bf16*)(ws + WS_WUP), FF, D, MS / 16, gw, NGW, lane, (bf16*)(ws + WS_F) + (size_t)MP * FF, nullptr);
    }
    SEAM(9);
    PRE(10) {
        if (IN(10)) {
            pg8::Gemm g{(const bf16*)(ws + WS_F), (const bf16*)(ws + WS_WDN), MP, D, FF}; pg8::StaticOrder S; S.init(MP, D, G, (int)blockIdx.x);
            pg8::EpiB16<0> E{(bf16*)(ws + WS_T2), D};
            pg8::gemm_phase<pg8::EpiB16<0>, pg8::StaticOrder, false, true>(ldsl, g, S, E);
            small_gemm<4>((const bf16*)(ws + WS_F) + (size_t)MP * FF, (const bf16*)(ws + WS_WDN), D, FF, MS / 16, gw, NGW, lane, (bf16*)(ws + WS_T2) + (size_t)MP * D, nullptr);
        }
        GSYNC(); }
    if (IN(10)) {
        pg8::Gemm g{(const bf16*)(ws + WS_F), (const bf16*)(ws + WS_WDN), MP, D, FF}; pg8::StaticOrder S; S.init(MP, D, G, (int)blockIdx.x);
        pg8::EpiB16<0> E{(bf16*)(ws + WS_T2), D};
        pg8::gemm_phase<pg8::EpiB16<0>, pg8::StaticOrder, false, true>(ldsl, g, S, E);
        small_gemm<4>((const bf16*)(ws + WS_F) + (size_t)MP * FF, (const bf16*)(ws + WS_WDN), D, FF, MS / 16, gw, NGW, lane, (bf16*)(ws + WS_T2) + (size_t)MP * D, nullptr);
    }
    SEAM(10);
    if (IN(11)) phase9(a, gw, NGW, lane);
#undef IN
#undef SEAM
}

#ifndef MK_SPLIT
#define MK_SPLIT 0
#endif
extern "C" void kernel_launch(void* const* d_in, const int* in_sizes, int n_in, void* d_out, int out_size, void* d_ws, size_t ws_size, hipStream_t stream) {
    static int grid = 0;
    if (grid == 0) {
        int dev = 0, cus = 0, per_cu = 0;
        if (hipGetDevice(&dev) != hipSuccess || hipDeviceGetAttribute(&cus, hipDeviceAttributeMultiprocessorCount, dev) != hipSuccess) { fprintf(stderr, "kernel_launch: device query failed\n"); grid = -1; return; }
        if (hipFuncSetAttribute((const void*)mk_fwd, hipFuncAttributeMaxDynamicSharedMemorySize, LDS_BYTES) != hipSuccess) { fprintf(stderr, "kernel_launch: hipFuncSetAttribute failed\n"); grid = -1; return; }
        if (hipOccupancyMaxActiveBlocksPerMultiprocessor(&per_cu, (const void*)mk_fwd, NWAVES * 64, LDS_BYTES) != hipSuccess || per_cu < 1) { fprintf(stderr, "kernel_launch: occupancy query says %d\n", per_cu); per_cu = 1; }
        (void)hipGetLastError();
        grid = cus;
        if (n_in != 23 || out_size != (int)O_END || ws_size < 256 * MiB) fprintf(stderr, "kernel_launch: unexpected sizes n_in %d out %d ws %zu\n", n_in, out_size, ws_size);
    }
    if (grid < 0) return;
    Args a{};
    const float** pp = (const float**)&a;
    for (int i = 0; i < 23; ++i) pp[i] = (const float*)d_in[i];
    a.out = (float*)d_out; a.ws = (unsigned char*)d_ws;
    if (hipMemsetAsync(d_ws, 0, CTL_ZERO_BYTES, stream) != hipSuccess) { fprintf(stderr, "kernel_launch: memset failed\n"); return; }
#if MK_SPLIT
    for (int p = 0; p < 12; ++p) { a.ph_lo = p; a.ph_hi = p + 1; hipLaunchKernelGGL(mk_fwd, dim3(grid), dim3(NWAVES * 64), LDS_BYTES, stream, a); }
#else
    a.ph_lo = 0; a.ph_hi = 12;
    void* args[] = {&a};
    hipError_t e = hipLaunchCooperativeKernel((const void*)mk_fwd, dim3(grid), dim3(NWAVES * 64), args, LDS_BYTES, stream);
    if (e != hipSuccess) fprintf(stderr, "cooperative launch failed: %s (grid %d)\n", hipGetErrorString(e), grid);
#endif
}
```

```cpp
#include <hip/hip_runtime.h>
#include <hip/hip_cooperative_groups.h>
#include <cstdio>
#include <cstdint>
namespace cg = cooperative_groups;
namespace pg8 {
#define PG8_LAS __attribute__((address_space(3)))
typedef unsigned short bf16_t;
typedef short bf16x8 __attribute__((ext_vector_type(8)));
typedef float f32x4 __attribute__((ext_vector_type(4)));
typedef unsigned u32x4 __attribute__((ext_vector_type(4)));
constexpr int BM = 256, BK = 64, HALF = 128, HTB = HALF * BK * 2  , STAGE_BYTES = 8 * HTB, NXCD = 8, WGM = 8;

__host__ __device__ __forceinline__ int lds_byte(int r, int c) { const int st = (r >> 4) * 2 + (c >> 5), rr = r & 15, cc = c & 31, ob = rr * 64 + cc * 2; return st * 1024 + (ob ^ (((ob >> 9) & 1) << 5)); }
__host__ __device__ __forceinline__ void stage_rc(int b, int& R, int& C) { const int st = b / 1024, sb = b % 1024, swz = sb ^ (((sb >> 9) & 1) << 5); R = (st >> 1) * 16 + swz / 64; C = (st & 1) * 32 + (swz % 64) / 2; }
__host__ __device__ __forceinline__ int perm32(int rho) { const int n = rho >> 4, i = rho & 15; return 8 * (i >> 2) + 4 * n + (i & 3); }

struct Unit { int pm, pn; };
struct Gemm { const bf16_t* A; const bf16_t* Bt; int M, N, K; };

struct StaticOrder {
    int nM, nN, nwg, G, c;
    __host__ __device__ void init(int M, int N, int G_, int c_) { nM = M / BM; nN = N / BM; nwg = nM * nN; G = G_; c = c_; }
    __host__ __device__ bool next(int i, Unit& u) const {
        const long L = (long)i * G + c; if (L >= nwg) return false;
        int wgid = (int)L; { const int q = nwg / NXCD, r = nwg % NXCD, xcd = wgid % NXCD, off = wgid / NXCD; wgid = (xcd < r ? xcd * (q + 1) : r * (q + 1) + (xcd - r) * q) + off; }
        const int nig = WGM * nN, gid = wgid / nig, fm = gid * WGM, gsz = (nM - fm) < WGM ? (nM - fm) : WGM;
        u.pm = fm + ((wgid % nig) % gsz); u.pn = (wgid % nig) / gsz; return true;
    }
    __device__ __forceinline__ void a_ready(const Unit&) const {}
    __device__ __forceinline__ void done(const Unit&) const {}
};

__device__ __forceinline__ unsigned cvt_pk_bf16(float lo, float hi) { unsigned r; asm volatile("v_cvt_pk_bf16_f32 %0, %1, %2" : "=v"(r) : "v"(lo), "v"(hi)); return r; }
template <int ACT  > struct EpiB16 {
    static constexpr bool PERM = true, AFTER_DRAIN = false;
    bf16_t* O; int ldc;
    __device__ __forceinline__ void operator()(const f32x4 (&acc)[2][2][4][2], const Unit& u, int wr, int wc, int fr, int fq) const {
        const int row0 = u.pm * BM + wr * 64 + fr; const int col0 = u.pn * BM + wc * 32 + 8 * fq;
#pragma unroll
        for (int ai = 0; ai < 2; ++ai)
#pragma unroll
            for (int m = 0; m < 4; ++m) { bf16_t* rowp = O + (size_t)(row0 + ai * HALF + m * 16) * ldc + col0;
#pragma unroll
                for (int bj = 0; bj < 2; ++bj) { f32x4 v0 = acc[ai][bj][m][0], v1 = acc[ai][bj][m][1];
                    if (ACT == 1) {
#pragma unroll
                        for (int i = 0; i < 4; ++i) { float a = fmaxf(v0[i], 0.f), b = fmaxf(v1[i], 0.f); v0[i] = a * a; v1[i] = b * b; } }
                    u32x4 w; w.x = cvt_pk_bf16(v0[0], v0[1]); w.y = cvt_pk_bf16(v0[2], v0[3]); w.z = cvt_pk_bf16(v1[0], v1[1]); w.w = cvt_pk_bf16(v1[2], v1[3]);
                    *(u32x4*)(rowp + bj * HALF) = w; } }
    }
};
struct EpiF32 {
    static constexpr bool PERM = false, AFTER_DRAIN = false;
    float* O; int ldc;
    __device__ __forceinline__ void operator()(const f32x4 (&acc)[2][2][4][2], const Unit& u, int wr, int wc, int fr, int fq) const {
#pragma unroll
        for (int ai = 0; ai < 2; ++ai)
#pragma unroll
            for (int m = 0; m < 4; ++m) { float* rowp = O + (size_t)(u.pm * BM + ai * HALF + wr * 64 + m * 16 + fr) * ldc + u.pn * BM + wc * 32 + 4 * fq;
#pragma unroll
                for (int bj = 0; bj < 2; ++bj)
#pragma unroll
                    for (int n = 0; n < 2; ++n) *(f32x4*)(rowp + bj * HALF + n * 16) = acc[ai][bj][m][n]; }
    }
};
struct EpiB16CM {
    static constexpr bool PERM = true, AFTER_DRAIN = false;
    bf16_t* O; int R;
    __device__ __forceinline__ void operator()(const f32x4 (&acc)[2][2][4][2], const Unit& u, int wr, int wc, int fr, int fq) const {
        const int row0 = u.pm * BM + wr * 64 + fr; const int col0 = u.pn * BM + wc * 32 + 8 * fq;
#pragma unroll
        for (int bj = 0; bj < 2; ++bj) { bf16_t* pl = O + ((size_t)((col0 + bj * HALF) >> 3) * R + row0) * 8;
#pragma unroll
            for (int ai = 0; ai < 2; ++ai)
#pragma unroll
                for (int m = 0; m < 4; ++m) { const f32x4 v0 = acc[ai][bj][m][0], v1 = acc[ai][bj][m][1];
                    u32x4 w; w.x = cvt_pk_bf16(v0[0], v0[1]); w.y = cvt_pk_bf16(v0[2], v0[3]); w.z = cvt_pk_bf16(v1[0], v1[1]); w.w = cvt_pk_bf16(v1[2], v1[3]);
                    *(u32x4*)(pl + (size_t)(ai * HALF + m * 16) * 8) = w; } }
    }
};
template <class Epi, class Sched, bool ALIGN_EPI = false, bool SP2 = false>
__device__ __forceinline__ void gemm_phase(PG8_LAS unsigned char* lds, const Gemm g, const Sched& S, const Epi& E) {
    const int tid = threadIdx.x, wid = __builtin_amdgcn_readfirstlane(tid >> 6), lane = tid & 63, wr = wid >> 2, wc = wid & 3, fr = lane & 15, fq = lane >> 4;
    const int K = g.K, nt = K / BK;
    unsigned voffA[2], voffB[2];
#pragma unroll
    for (int i = 0; i < 2; ++i) { int R, C; stage_rc(tid * 16 + i * 8192, R, C); const int Rb = Epi::PERM ? ((R & ~31) + perm32(R & 31)) : R;
        voffA[i] = (unsigned)(R * K + C) * 2u; voffB[i] = (unsigned)(Rb * K + C) * 2u; }
    const size_t kstep = (size_t)(BK * 2);
    const size_t hstep = (size_t)HALF * K * 2;
    const size_t tstep = 2 * hstep;
    const unsigned ldsw = (unsigned)wid * 1024u;
    const int aoff = lds_byte(wr * 64 + fr, fq * 8), boff = lds_byte(wc * 32 + fr, fq * 8);
#define PG8_SA(b, h) (((b) * 2 + (h)) * HTB)
#define PG8_SB(b, h) ((4 + (b) * 2 + (h)) * HTB)
#define PG8_STAGE(bufoff, gbase, voff) do { _Pragma("unroll") for (int _i = 0; _i < 2; ++_i) \
        __builtin_amdgcn_global_load_lds((const unsigned*)((const char*)(gbase) + (voff)[_i]), (PG8_LAS unsigned*)(lds + (bufoff) + ldsw + _i * 8192), 16, 0, 0); } while (0)
#define PG8_LDA(dst, b, h) do { _Pragma("unroll") for (int m = 0; m < 4; ++m) _Pragma("unroll") for (int k = 0; k < 2; ++k) dst[m][k] = *(const PG8_LAS bf16x8*)(lds + PG8_SA(b, h) + aoff + m * 2048 + k * 1024); } while (0)
#define PG8_LDB(dst, b, h) do { _Pragma("unroll") for (int n = 0; n < 2; ++n) _Pragma("unroll") for (int k = 0; k < 2; ++k) dst[n][k] = *(const PG8_LAS bf16x8*)(lds + PG8_SB(b, h) + boff + n * 2048 + k * 1024); } while (0)
#define PG8_MMA(ai, bj, At, Bt) do { __builtin_amdgcn_s_setprio(1); _Pragma("unroll") for (int m = 0; m < 4; ++m) _Pragma("unroll") for (int n = 0; n < 2; ++n) _Pragma("unroll") for (int k = 0; k < 2; ++k) \
        acc[ai][bj][m][n] = __builtin_amdgcn_mfma_f32_16x16x32_bf16(Bt[n][k], At[m][k], acc[ai][bj][m][n], 0, 0, 0); __builtin_amdgcn_s_setprio(0); } while (0)
#define PG8_WAIT_V(n) asm volatile("s_waitcnt vmcnt(" #n ")" ::: "memory")
#define PG8_WAIT_L(n) asm volatile("s_waitcnt lgkmcnt(" #n ")" ::: "memory")
#define PG8_BAR __builtin_amdgcn_s_barrier()
#define PG8_SCHED __builtin_amdgcn_sched_barrier(0)
    Unit cur, nxt; int ui = 0;
    if (!S.next(0, cur)) return;
    f32x4 acc[2][2][4][2];
#pragma unroll
    for (int a = 0; a < 2; ++a)
#pragma unroll
        for (int b = 0; b < 2; ++b)
#pragma unroll
            for (int m = 0; m < 4; ++m)
#pragma unroll
                for (int n = 0; n < 2; ++n) acc[a][b][m][n] = (f32x4){0.f, 0.f, 0.f, 0.f};
    bf16x8 At[4][2], B0[2][2], B1[2][2];
    const char* cA = (const char*)g.A + (size_t)cur.pm * tstep; const char* cB = (const char*)g.Bt + (size_t)cur.pn * tstep;
    S.a_ready(cur);
    if constexpr (SP2) {
        PG8_STAGE(PG8_SB(0, 0), cB, voffB); PG8_STAGE(PG8_SB(0, 1), cB + hstep, voffB); PG8_STAGE(PG8_SA(0, 0), cA, voffA); PG8_STAGE(PG8_SA(0, 1), cA + hstep, voffA);
        if (wr == 1) PG8_BAR;
        PG8_WAIT_V(2); PG8_BAR;
        PG8_STAGE(PG8_SB(1, 0), cB + kstep, voffB); PG8_STAGE(PG8_SA(1, 0), cA + kstep, voffA); PG8_STAGE(PG8_SB(1, 1), cB + hstep + kstep, voffB);
        PG8_WAIT_V(6); PG8_BAR;
    } else {
        PG8_STAGE(PG8_SB(0, 0), cB, voffB); PG8_STAGE(PG8_SA(0, 0), cA, voffA); PG8_STAGE(PG8_SB(0, 1), cB + hstep, voffB); PG8_STAGE(PG8_SA(0, 1), cA + hstep, voffA);
        if (wr == 1) PG8_BAR;
        PG8_WAIT_V(4); PG8_BAR;
        PG8_STAGE(PG8_SB(1, 0), cB + kstep, voffB); PG8_STAGE(PG8_SA(1, 0), cA + kstep, voffA); PG8_STAGE(PG8_SB(1, 1), cB + hstep + kstep, voffB);
        PG8_WAIT_V(6); PG8_BAR;
    }
    for (;;) {
        const bool has_next = S.next(ui + 1, nxt);
        const char* nA = has_next ? (const char*)g.A + (size_t)nxt.pm * tstep : cA; const char* nB = has_next ? (const char*)g.Bt + (size_t)nxt.pn * tstep : cB;
        for (int t = 0; t < nt; t += 2) {
            const bool last = (t == nt - 2);
            const char* a1 = cA + (size_t)(t + 1) * kstep;
            const char* a2 = last ? nA : cA + (size_t)(t + 2) * kstep; const char* b2 = last ? nB : cB + (size_t)(t + 2) * kstep;
            const char* a3 = a2 + kstep; const char* b3 = b2 + kstep;
            if (last && has_next) S.a_ready(nxt);
            if constexpr (SP2) {
            PG8_LDB(B0, 0, 0); PG8_LDB(B1, 0, 1); PG8_SCHED; PG8_LDA(At, 0, 0); PG8_STAGE(PG8_SA(1, 1), a1 + hstep, voffA);
            PG8_WAIT_V(8); PG8_WAIT_L(0); PG8_BAR; PG8_MMA(0, 0, At, B0); PG8_MMA(0, 1, At, B1); PG8_BAR; PG8_SCHED;
            PG8_LDA(At, 0, 1); PG8_STAGE(PG8_SB(0, 0), b2, voffB); PG8_STAGE(PG8_SB(0, 1), b2 + hstep, voffB); PG8_STAGE(PG8_SA(0, 0), a2, voffA);
            PG8_WAIT_V(8); PG8_WAIT_L(0); PG8_BAR; PG8_MMA(1, 0, At, B0); PG8_MMA(1, 1, At, B1); PG8_BAR; PG8_SCHED;
            PG8_LDB(B0, 1, 0); PG8_LDB(B1, 1, 1); PG8_SCHED; PG8_LDA(At, 1, 0); PG8_STAGE(PG8_SA(0, 1), a2 + hstep, voffA);
            PG8_WAIT_V(8); PG8_WAIT_L(0); PG8_BAR; PG8_MMA(0, 0, At, B0); PG8_MMA(0, 1, At, B1); PG8_BAR; PG8_SCHED;
            PG8_LDA(At, 1, 1); PG8_STAGE(PG8_SB(1, 0), b3, voffB); PG8_STAGE(PG8_SB(1, 1), b3 + hstep, voffB); PG8_STAGE(PG8_SA(1, 0), a3, voffA);
            PG8_WAIT_V(8); PG8_WAIT_L(0); PG8_BAR; PG8_MMA(1, 0, At, B0); PG8_MMA(1, 1, At, B1); PG8_BAR; PG8_SCHED;
            } else {
            PG8_LDB(B0, 0, 0); PG8_SCHED; PG8_LDA(At, 0, 0); PG8_STAGE(PG8_SA(1, 1), a1 + hstep, voffA);
            PG8_WAIT_L(8); PG8_BAR; PG8_WAIT_L(0); PG8_MMA(0, 0, At, B0); PG8_BAR; PG8_SCHED;
            PG8_LDB(B1, 0, 1); PG8_STAGE(PG8_SB(0, 0), b2, voffB);
            PG8_BAR; PG8_WAIT_L(0); PG8_MMA(0, 1, At, B1); PG8_BAR;
            PG8_LDA(At, 0, 1); PG8_STAGE(PG8_SA(0, 0), a2, voffA);
            PG8_BAR; PG8_WAIT_L(0); PG8_MMA(1, 0, At, B0); PG8_BAR; PG8_SCHED;
            PG8_STAGE(PG8_SB(0, 1), b2 + hstep, voffB);
            PG8_WAIT_V(6); PG8_BAR; PG8_MMA(1, 1, At, B1); PG8_BAR;
            PG8_LDB(B0, 1, 0); PG8_SCHED; PG8_LDA(At, 1, 0); PG8_STAGE(PG8_SA(0, 1), a2 + hstep, voffA);
            PG8_WAIT_L(8); PG8_BAR; PG8_WAIT_L(0); PG8_MMA(0, 0, At, B0); PG8_BAR; PG8_SCHED;
            PG8_LDB(B1, 1, 1); PG8_STAGE(PG8_SB(1, 0), b3, voffB);
            PG8_BAR; PG8_WAIT_L(0); PG8_MMA(0, 1, At, B1); PG8_BAR;
            PG8_LDA(At, 1, 1); PG8_STAGE(PG8_SA(1, 0), a3, voffA);
            PG8_BAR; PG8_WAIT_L(0); PG8_MMA(1, 0, At, B0); PG8_BAR; PG8_SCHED;
            PG8_STAGE(PG8_SB(1, 1), b3 + hstep, voffB);
            PG8_WAIT_V(6); PG8_BAR; PG8_MMA(1, 1, At, B1); PG8_BAR;
            }
        }
        if constexpr (ALIGN_EPI) { if (wr == 0) PG8_BAR; }
        if constexpr (!Epi::AFTER_DRAIN) { E(acc, cur, wr, wc, fr, fq); S.done(cur); }
        if (!has_next) break;
#pragma unroll
        for (int a = 0; a < 2; ++a)
#pragma unroll
            for (int b = 0; b < 2; ++b)
#pragma unroll
                for (int m = 0; m < 4; ++m)
#pragma unroll
                    for (int n = 0; n < 2; ++n) acc[a][b][m][n] = (f32x4){0.f, 0.f, 0.f, 0.f};
        cur = nxt; cA = nA; cB = nB; ++ui;
        if constexpr (ALIGN_EPI) { if (wr == 1) PG8_BAR; }
    }
    PG8_WAIT_V(0);
    if constexpr (!ALIGN_EPI) { if (wr == 0) PG8_BAR; }
    PG8_BAR;
    if constexpr (Epi::AFTER_DRAIN) { E.fused(acc, cur, wr, wc, fr, fq, lds, wid, lane); S.done(cur); }
#undef PG8_SA
#undef PG8_SB
#undef PG8_STAGE
#undef PG8_LDA
#undef PG8_LDB
#undef PG8_MMA
#undef PG8_WAIT_V
#undef PG8_WAIT_L
#undef PG8_BAR
#undef PG8_SCHED
}
}

constexpr int D = 1024, MP = 16384, MS = 128, MT = MP + MS, SEQ = 2048, NBATCH = 8, FF = 4096;
constexpr int NZ = 2048;
constexpr int ZR = 16400;
constexpr int ZTR = 1040;
__device__ __forceinline__ size_t zc(int row, int col) { return ((size_t)(col >> 3) * ZR + row) * 8 + (col & 7); }
__device__ __forceinline__ size_t ztc(int wrow, int tok) { return ((size_t)(tok >> 3) * ZTR + wrow) * 8 + (tok & 7); }
constexpr int NZS = 2560;
constexpr int INC = 2568;
constexpr int NMOD = 136, NMODP = 144, MODC = 6144;
constexpr int NCH = 32;
constexpr int NITEM = 1024;
constexpr float EPS = 1e-6f;
constexpr float KSCALE = 0.08838834764831845f;

constexpr size_t MiB = 1u << 20;
constexpr size_t WS_WIN = 2 * MiB, WS_WOUT = 8 * MiB, WS_WUP = 10 * MiB, WS_WDN = 18 * MiB, WS_WADA = 26 * MiB, WS_WPOOL = 38 * MiB;
constexpr size_t WS_SILU = 38 * MiB + 256 * 1024, WS_MOD = 39 * MiB, WS_GATES = 43 * MiB;
constexpr size_t WS_CHB = 44 * MiB, WS_CHM = WS_CHB + 4096, WS_MST = WS_CHM + 4096, WS_NU = 44 * MiB + 256 * 1024, WS_NST = 44 * MiB + 768 * 1024, WS_ZS = 45 * MiB + 512 * 1024;
constexpr size_t WS_H = 47 * MiB;
constexpr size_t WS_Z = 80 * MiB;
constexpr size_t WS_ZT = 146 * MiB;
constexpr size_t WS_U = 179 * MiB;
constexpr size_t WS_CST = WS_U;
constexpr size_t WS_T1 = 80 * MiB;
constexpr size_t WS_F = 80 * MiB;
constexpr size_t WS_T2 = WS_H;
constexpr size_t WS_WINC = 211 * MiB, WS_WOUTC = 217 * MiB, WS_WUPC = 219 * MiB, WS_WDNC = 227 * MiB;
constexpr size_t WS_HNS = 235 * MiB, WS_MIXS = WS_HNS + 256 * 1024, WS_FS = 236 * MiB;
static_assert(WS_ZS + (size_t)MS * NZS * 2 <= WS_H && WS_H + (size_t)MT * D * 2 <= WS_Z && WS_Z + (size_t)(NZ / 8) * ZR * 16 <= WS_ZT && WS_ZT + (size_t)(MP / 8) * ZTR * 16 <= WS_U && WS_U + 32 * MiB <= 256 * MiB, "ws map");
static_assert(WS_F + (size_t)MT * FF * 2 <= WS_WINC && WS_U + 32 * MiB <= WS_WINC && WS_T1 + (size_t)MT * D * 4 <= WS_U && WS_FS + MiB <= 256 * MiB, "ws map 2");

constexpr size_t O_YP = 0, O_YS = 16777216, O_CP = 16908288, O_NP = 17432576, O_MP = 17436672, O_PP = 17436704, O_CS = 17498144, O_NS = 25886752, O_MS = 25952288, O_PS = 25952800, O_END = 26935840;

constexpr int LDS_BYTES = 147456;
constexpr int CW_BAR = 4096;
constexpr size_t CTL_ZERO_BYTES = 65536;
constexpr int NWAVES = 8;

typedef unsigned short bf16;
typedef unsigned u32x4 __attribute__((ext_vector_type(4)));
typedef unsigned u32x2 __attribute__((ext_vector_type(2)));
typedef float f32x4 __attribute__((ext_vector_type(4)));
typedef short bf16x8 __attribute__((ext_vector_type(8)));

struct Args {
    const float *x_prompt, *x_sample, *c_prompt, *c_sample, *state_C, *state_n, *state_m, *state_pool, *w_ada, *b_ada, *g_pre1, *g_post1, *w_in, *b_ig, *b_fg, *g_head, *w_pool,
        *pool_scale, *w_out, *g_pre2, *g_post2, *w_up, *w_down;
    float* out; unsigned char* ws;
    int ph_lo, ph_hi;
};

__device__ __forceinline__ unsigned f2bf(float f) { unsigned u = __builtin_bit_cast(unsigned, f); return (u + 0x7fffu + ((u >> 16) & 1u)) >> 16; }
typedef float f32x2_t __attribute__((ext_vector_type(2)));
typedef __bf16 bf16x2_t __attribute__((ext_vector_type(2)));
__device__ __forceinline__ unsigned pk2(float lo, float hi) { f32x2_t v = {lo, hi}; bf16x2_t b = __builtin_convertvector(v, bf16x2_t); return __builtin_bit_cast(unsigned, b); }
__device__ __forceinline__ float bf2f(unsigned h) { return __builtin_bit_cast(float, h << 16); }
__device__ __forceinline__ float bflo(unsigned w) { return __builtin_bit_cast(float, w << 16); }
__device__ __forceinline__ float bfhi(unsigned w) { return __builtin_bit_cast(float, w & 0xffff0000u); }
__device__ __forceinline__ float wave_sum(float v) {
#pragma unroll
    for (int o = 1; o < 64; o <<= 1) v += __shfl_xor(v, o);
    return v;
}
__device__ __forceinline__ float wave_max(float v) {
#pragma unroll
    for (int o = 1; o < 64; o <<= 1) v = fmaxf(v, __shfl_xor(v, o));
    return v;
}
__device__ __forceinline__ float sigmoidf_(float x) { return 1.f / (1.f + __expf(-x)); }
__device__ __forceinline__ int mod_row(int row) { return row < MP ? (row >> 11) : (NBATCH + row - MP); }
__device__ __forceinline__ f32x4 mfma16(bf16x8 a, bf16x8 b, f32x4 c) { return __builtin_amdgcn_mfma_f32_16x16x32_bf16(a, b, c, 0, 0, 0); }

__device__ __forceinline__ void transpose_item(const float* W, int ldw, int nblk, int K, bf16* WT, float* scr, int item, int lane, float scale, int cmR = 0, bf16* WT2 = nullptr, int cmR2 = 0) {
    const int kb = item / nblk, nb = item % nblk, k0 = 64 * kb, n0 = 32 * nb;
#pragma unroll 8
    for (int i = 0; i < 32; ++i) { const int kk = 2 * i + (lane >> 5); scr[kk * 33 + (lane & 31)] = W[(size_t)(k0 + kk) * ldw + n0 + (lane & 31)] * scale; }
    asm volatile("s_waitcnt lgkmcnt(0)" ::: "memory");
    const int c = lane & 7;
#pragma unroll
    for (int j = 0; j < 4; ++j) { const int n = (lane >> 3) + 8 * j; const float* s = scr + (8 * c) * 33 + n;
        u32x4 o; o.x = pk2(s[0 * 33], s[1 * 33]); o.y = pk2(s[2 * 33], s[3 * 33]); o.z = pk2(s[4 * 33], s[5 * 33]); o.w = pk2(s[6 * 33], s[7 * 33]);
        if (cmR) *(u32x4*)(WT + ((size_t)((k0 >> 3) + c) * cmR + n0 + n) * 8) = o; else *(u32x4*)(WT + (size_t)(n0 + n) * K + k0 + 8 * c) = o;
        if (WT2) *(u32x4*)(WT2 + ((size_t)((k0 >> 3) + c) * cmR2 + n0 + n) * 8) = o; }
    asm volatile("s_waitcnt lgkmcnt(0)" ::: "memory");
}

__device__ __forceinline__ void phase0(const Args& a, unsigned char* lds, int gw, int NGW, int lane, int wave) {
    float* scr = (float*)(lds + wave * 16384);
    unsigned char* ws = a.ws;
    constexpr int I_IN = 6 * 256, I_OUT = 16 * 32, I_UP = 16 * 128, I_DN = 64 * 32, I_ADA = 16 * 192, I_POOL = 32;
    constexpr int NIT = I_IN + I_OUT + I_UP + I_DN + I_ADA + I_POOL;
    for (int it = gw; it < NIT; it += NGW) {
        int r = it;
        if (r < I_IN) { const int blk = r >> 8, rr = r & 255;
            const int src = blk == 0 ? 0 : blk == 1 ? 512 : blk == 2 ? 512 : blk == 3 ? 1024 : blk == 4 ? 1536 : 2056;
            const int dst = blk == 0 ? 0 : blk == 1 ? 512 : blk == 2 ? 2048 : blk == 3 ? 2560 : blk == 4 ? 1024 : 1536;
            transpose_item(a.w_in + src, INC, 16, D, (bf16*)(ws + WS_WIN) + (size_t)dst * D, scr, rr, lane, (blk == 1 || blk == 2) ? KSCALE : 1.f, 0, (bf16*)(ws + WS_WINC) + (size_t)dst * 8, 3072); continue; } r -= I_IN;
        if (r < I_OUT) { transpose_item(a.w_out, D, 32, D, (bf16*)(ws + WS_WOUT), scr, r, lane, 1.f, 0, (bf16*)(ws + WS_WOUTC), D); continue; } r -= I_OUT;
        if (r < I_UP) { transpose_item(a.w_up, FF, 128, D, (bf16*)(ws + WS_WUP), scr, r, lane, 1.f, 0, (bf16*)(ws + WS_WUPC), FF); continue; } r -= I_UP;
        if (r < I_DN) { transpose_item(a.w_down, D, 32, FF, (bf16*)(ws + WS_WDN), scr, r, lane, 1.f, 0, (bf16*)(ws + WS_WDNC), D); continue; } r -= I_DN;
        if (r < I_ADA) { transpose_item(a.w_ada, MODC, 192, D, (bf16*)(ws + WS_WADA), scr, r, lane, 1.f, MODC); continue; } r -= I_ADA;
        { const int g = r >> 3; transpose_item(a.w_pool + g * 16384, 128, 4, 128, (bf16*)(ws + WS_WPOOL) + g * 16384, scr, r & 7, lane, 1.f, 128); }
    }
    bf16* S = (bf16*)(ws + WS_SILU);
    for (int i = gw * 64 + lane; i < NMODP * D; i += NGW * 64) {
        const int row = i >> 10, col = i & 1023; float v = 0.f;
        if (row < NBATCH) v = a.c_prompt[row * D + col]; else if (row < NMOD) v = a.c_sample[(row - NBATCH) * D + col];
        S[((size_t)(col >> 3) * NMODP + row) * 8 + (col & 7)] = (bf16)f2bf(v * sigmoidf_(v));
    }
}

__device__ __forceinline__ size_t cm128(int row, int col) { return ((size_t)(col >> 3) * 128 + row) * 8 + (col & 7); }
template <int MODE> __device__ __forceinline__ void small_gemm(const bf16* Ac, int RA, const bf16* Bc, int RB, int Ncols, int K, int Mtiles, int gw, int NGW, int lane_, void* outp, const float* bias) {
    int lane = lane_; asm volatile("" : "+v"(lane));
    const int fr = lane & 15, fq = lane >> 4;
    const int ntile = Mtiles * (Ncols >> 4);
    for (int tile = gw; tile < ntile; tile += NGW) {
        const int mt = tile % Mtiles, nt = tile / Mtiles;
        const int brow = (MODE == 1 && nt >= 128) ? (nt + 32) * 16 : nt * 16;
        const bf16* apc = Ac + ((size_t)fq * RA + mt * 16 + fr) * 8; const bf16* bpc = Bc + ((size_t)fq * RB + brow + fr) * 8;
        f32x4 acc = (f32x4){0.f, 0.f, 0.f, 0.f};
#pragma unroll 8
        for (int k8 = 0; k8 < K / 8; k8 += 4) { const bf16x8 av = *(const bf16x8*)(apc + (size_t)k8 * RA * 8); const bf16x8 bv = *(const bf16x8*)(bpc + (size_t)k8 * RB * 8); acc = mfma16(av, bv, acc); }
        const int col = nt * 16 + fr;
#pragma unroll
        for (int j = 0; j < 4; ++j) { const int row = mt * 16 + fq * 4 + j; const float v = acc[j];
            if (MODE == 0) { if (row < NMOD) ((float*)outp)[(size_t)row * MODC + col] = v + bias[col]; }
            else if (MODE == 1) ((bf16*)outp)[(size_t)row * NZS + col] = (bf16)f2bf(v);
            else if (MODE == 2) ((float*)outp)[(size_t)row * D + col] = v;
            else { const float r = fmaxf(v, 0.f); ((bf16*)outp)[cm128(row, col)] = (bf16)f2bf(r * r); } }
    }
}
__device__ __forceinline__ void small_gemm_down(const bf16* Ac, const bf16* Bc, unsigned char* lds, int lane, int wave, bf16* outp) {
    const int fr = lane & 15, fq = lane >> 4, tsel = wave >> 2, kq = wave & 3;
    f32x4* red = (f32x4*)lds;
    for (int tp = blockIdx.x; tp < 256; tp += gridDim.x) {
        const int tile = tp * 2 + tsel, mt = tile & 7, nt = tile >> 3;
        const bf16* apc = Ac + ((size_t)(kq * 128 + fq) * 128 + mt * 16 + fr) * 8; const bf16* bpc = Bc + ((size_t)(kq * 128 + fq) * D + nt * 16 + fr) * 8;
        f32x4 acc = (f32x4){0.f, 0.f, 0.f, 0.f};
#pragma unroll 8
        for (int k8 = 0; k8 < 128; k8 += 4) { const bf16x8 av = *(const bf16x8*)(apc + (size_t)k8 * 128 * 8); const bf16x8 bv = *(const bf16x8*)(bpc + (size_t)k8 * D * 8); acc = mfma16(av, bv, acc); }
        red[wave * 64 + lane] = acc;
        __syncthreads();
        if (kq == 0) { const f32x4 t = (red[wave * 64 + lane] + red[(wave + 1) * 64 + lane]) + (red[(wave + 2) * 64 + lane] + red[(wave + 3) * 64 + lane]);
#pragma unroll
            for (int j = 0; j < 4; ++j) outp[(size_t)(mt * 16 + fq * 4 + j) * D + nt * 16 + fr] = (bf16)f2bf(t[j]); }
        __syncthreads();
    }
}

__device__ __forceinline__ void phase1a(const Args& a, unsigned char* lds, int gw, int NGW, int lane, int tid) {
    f32x4* wg4 = (f32x4*)lds;
    for (int i = tid; i < 2048; i += 512) { const int k = i >> 1, hf = i & 1; wg4[i] = *(const f32x4*)(a.w_in + (size_t)k * INC + 2048 + hf * 4); }
    __syncthreads();
    const float* MOD = (const float*)(a.ws + WS_MOD); bf16* HN = (bf16*)(a.ws + WS_H); float* GATES = (float*)(a.ws + WS_GATES);
    for (int row = gw; row < MT; row += NGW) {
        const float* xr = row < MP ? a.x_prompt + (size_t)row * D : a.x_sample + (size_t)(row - MP) * D;
        const float* md = MOD + (size_t)mod_row(row) * MODC;
        f32x4 v[4]; float ss = 0.f;
#pragma unroll
        for (int j = 0; j < 4; ++j) { v[j] = *(const f32x4*)(xr + j * 256 + lane * 4); ss += (v[j][0] * v[j][0] + v[j][1] * v[j][1]) + (v[j][2] * v[j][2] + v[j][3] * v[j][3]); }
        const float rstd = rsqrtf(wave_sum(ss) * (1.f / D) + EPS);
        float g0 = 0.f, g1 = 0.f, g2 = 0.f, g3 = 0.f, g4 = 0.f, g5 = 0.f, g6 = 0.f, g7 = 0.f;
#pragma unroll
        for (int j = 0; j < 4; ++j) { const int col = j * 256 + lane * 4;
            const f32x4 gp = *(const f32x4*)(a.g_pre1 + col), sh = *(const f32x4*)(md + col), sc = *(const f32x4*)(md + D + col);
            f32x4 h = v[j] * rstd * gp * (sc + 1.f) + sh;
            u32x2 o; o.x = pk2(h[0], h[1]); o.y = pk2(h[2], h[3]); *(u32x2*)(HN + (size_t)row * D + col) = o;
            if (row >= MP) *(u32x2*)((bf16*)(a.ws + WS_HNS) + cm128(row - MP, col)) = o;
#pragma unroll
            for (int i = 0; i < 4; ++i) { const f32x4 w0 = wg4[(col + i) * 2], w1 = wg4[(col + i) * 2 + 1]; const float hv = h[i];
                g0 += hv * w0[0]; g1 += hv * w0[1]; g2 += hv * w0[2]; g3 += hv * w0[3]; g4 += hv * w1[0]; g5 += hv * w1[1]; g6 += hv * w1[2]; g7 += hv * w1[3]; } }
        g0 = wave_sum(g0); g1 = wave_sum(g1); g2 = wave_sum(g2); g3 = wave_sum(g3); g4 = wave_sum(g4); g5 = wave_sum(g5); g6 = wave_sum(g6); g7 = wave_sum(g7);
        if (lane == 0) {
            f32x4 ig = (f32x4){g0 + a.b_ig[0], g1 + a.b_ig[1], g2 + a.b_ig[2], g3 + a.b_ig[3]};
            f32x4 fg = (f32x4){g4 + a.b_fg[0], g5 + a.b_fg[1], g6 + a.b_fg[2], g7 + a.b_fg[3]}; f32x4 lf;
#pragma unroll
            for (int i = 0; i < 4; ++i) lf[i] = fminf(fg[i], 0.f) - log1pf(expf(-fabsf(fg[i])));
            *(f32x4*)(GATES + (size_t)row * 8) = ig; *(f32x4*)(GATES + (size_t)row * 8 + 4) = lf;
        }
    }
    __syncthreads();
}

__device__ __forceinline__ float scan_add(float v, int lane) {
#pragma unroll
    for (int o = 1; o < 64; o <<= 1) { const float t = __shfl_up(v, o); if (lane >= o) v += t; }
    return v;
}
__device__ __forceinline__ float scan_max(float v, int lane) {
#pragma unroll
    for (int o = 1; o < 64; o <<= 1) { const float t = __shfl_up(v, o); if (lane >= o) v = fmaxf(v, t); }
    return v;
}
__device__ __forceinline__ bf16x8 as_bf16x8(u32x4 v) { return __builtin_bit_cast(bf16x8, v); }

__device__ __forceinline__ void p2_chunk_job(const Args& a, int job, int lane_) {
    int lane = lane_; asm volatile("" : "+v"(lane));
    const int it = job >> 2, ep = job & 3, bh = it >> 5, c = it & 31, b = bh >> 2, h = bh & 3, r0 = b * SEQ + c * 64;
    const int fr = lane & 15, fq = lane >> 4;
    const float* GATES = (const float*)(a.ws + WS_GATES); const bf16* ZT = (const bf16*)(a.ws + WS_ZT);
    const float lf = GATES[(size_t)(r0 + lane) * 8 + 4 + h], ig = GATES[(size_t)(r0 + lane) * 8 + h];
    u32x4 raw[2][2]; bf16x8 ka[8][2];
#pragma unroll
    for (int ei = 0; ei < 2; ++ei)
#pragma unroll
        for (int ks = 0; ks < 2; ++ks) raw[ei][ks] = *(const u32x4*)(ZT + ztc(512 + h * 128 + (ep * 2 + ei) * 16 + fr, r0 + ks * 32 + fq * 8));
#pragma unroll
    for (int dt = 0; dt < 8; ++dt) { ka[dt][0] = *(const bf16x8*)(ZT + ztc(h * 128 + dt * 16 + fr, r0 + fq * 8)); ka[dt][1] = *(const bf16x8*)(ZT + ztc(h * 128 + dt * 16 + fr, r0 + 32 + fq * 8)); }
    __builtin_amdgcn_sched_barrier(0);
    const float bs = scan_add(lf, lane); const float B = __shfl(bs, 63); const float val = B - bs + ig; const float mloc = wave_max(val); const float wL = __expf(val - mloc);
    if (ep == 0 && lane == 0) { ((float*)(a.ws + WS_CHB))[it] = B; ((float*)(a.ws + WS_CHM))[it] = mloc; }
    float wv[2][8];
#pragma unroll
    for (int ks = 0; ks < 2; ++ks)
#pragma unroll
        for (int jj = 0; jj < 8; ++jj) wv[ks][jj] = __shfl(wL, ks * 32 + fq * 8 + jj);
    bf16x8 vb[2][2], wf[2];
#pragma unroll
    for (int ks = 0; ks < 2; ++ks) { u32x4 w; w.x = pk2(wv[ks][0], wv[ks][1]); w.y = pk2(wv[ks][2], wv[ks][3]); w.z = pk2(wv[ks][4], wv[ks][5]); w.w = pk2(wv[ks][6], wv[ks][7]); wf[ks] = as_bf16x8(w);
#pragma unroll
        for (int ei = 0; ei < 2; ++ei) { u32x4 o;
#pragma unroll
            for (int q = 0; q < 4; ++q) o[q] = pk2(bflo(raw[ei][ks][q]) * wv[ks][2 * q], bfhi(raw[ei][ks][q]) * wv[ks][2 * q + 1]);
            vb[ei][ks] = as_bf16x8(o); } }
    bf16* U = (bf16*)(a.ws + WS_U) + (size_t)it * 16384;
#pragma unroll
    for (int dt = 0; dt < 8; ++dt) {
        const bf16x8 a0 = ka[dt][0], a1 = ka[dt][1];
#pragma unroll
        for (int ei = 0; ei < 2; ++ei) { f32x4 acc = mfma16(a0, vb[ei][0], (f32x4){0.f, 0.f, 0.f, 0.f}); acc = mfma16(a1, vb[ei][1], acc);
            u32x2 o; o.x = pk2(acc[0], acc[1]); o.y = pk2(acc[2], acc[3]);
            *(u32x2*)(U + ((dt * 2 + (fq >> 1)) * 128 + (ep * 2 + ei) * 16 + fr) * 8 + (fq & 1) * 4) = o; }
        if ((dt >> 1) == ep) { f32x4 accn = mfma16(a0, wf[0], (f32x4){0.f, 0.f, 0.f, 0.f}); accn = mfma16(a1, wf[1], accn);
            if (fr == 0) *(f32x4*)((float*)(a.ws + WS_NU) + (size_t)it * 128 + dt * 16 + fq * 4) = accn; }
    }
}

#define POOL_WLOAD() bf16x8 wa[8]; do { _Pragma("unroll") for (int dt = 0; dt < 8; ++dt) wa[dt] = *(const bf16x8*)(WP + wofs + dt * 128 + ks * 4096); } while (0)
#define POOL_MMA_STEP() do { _Pragma("unroll") for (int dt = 0; dt < 8; ++dt) acc[dt] = mfma16(wa[dt], pfk, acc[dt]); } while (0)
#define POOL_STORE(mixrow) do { _Pragma("unroll") for (int dt = 0; dt < 8; ++dt) { const f32x4 sc = *(const f32x4*)(a.pool_scale + gi * 128 + dt * 16 + fq * 4); \
        u32x2 o; o.x = pk2(acc[dt][0] * sc[0], acc[dt][1] * sc[1]); o.y = pk2(acc[dt][2] * sc[2], acc[dt][3] * sc[3]); \
        if (SAMPLE_STORE) *(u32x2*)((bf16*)(a.ws + WS_MIXS) + cm128((mixrow), 512 + gi * 128 + dt * 16 + fq * 4)) = o; \
        else *(u32x2*)((bf16*)(a.ws + WS_H) + (size_t)(mixrow) * D + 512 + gi * 128 + dt * 16 + fq * 4) = o; } } while (0)

template <int WIN> __device__ __forceinline__ void pool_prompt_body(const Args& a, int b, int t0, int gi, int lane_) {
    int lane = lane_; asm volatile("" : "+v"(lane));
    const int fr = lane & 15, fq = lane >> 4, t = t0 + fr;
    const bf16* Z = (const bf16*)(a.ws + WS_Z); const bf16* WP = (const bf16*)(a.ws + WS_WPOOL) + gi * 16384; const int wofs = (fq * 128 + fr) * 8;
    const float inv = 1.f / (float)min(t + 1, WIN);
    f32x4 acc[8];
#pragma unroll
    for (int dt = 0; dt < 8; ++dt) acc[dt] = (f32x4){0.f, 0.f, 0.f, 0.f};
#pragma unroll 1
    for (int ks = 0; ks < 4; ++ks) { const int c0 = ks * 32 + fq * 8;
        const bf16* ub = Z + zc(b * SEQ, 1536 + gi * 128 + c0);
        POOL_WLOAD();
        u32x4 w[WIN];
#pragma unroll
        for (int jj = 0; jj < WIN; ++jj) { const int tj = max(t - jj, 0); w[jj] = *(const u32x4*)(ub + (size_t)tj * 8); }
        __builtin_amdgcn_sched_barrier(0);
        const u32x4 u0 = w[0];
        float s0 = bflo(u0[0]), s1 = bfhi(u0[0]), s2 = bflo(u0[1]), s3 = bfhi(u0[1]), s4 = bflo(u0[2]), s5 = bfhi(u0[2]), s6 = bflo(u0[3]), s7 = bfhi(u0[3]);
#pragma unroll
        for (int jj = 1; jj < WIN; ++jj) { const float vld = (t - jj >= 0) ? 1.f : 0.f;
            s0 += bflo(w[jj][0]) * vld; s1 += bfhi(w[jj][0]) * vld; s2 += bflo(w[jj][1]) * vld; s3 += bfhi(w[jj][1]) * vld;
            s4 += bflo(w[jj][2]) * vld; s5 += bfhi(w[jj][2]) * vld; s6 += bflo(w[jj][3]) * vld; s7 += bfhi(w[jj][3]) * vld; }
        u32x4 o; o.x = pk2(s0 * inv - bflo(u0[0]), s1 * inv - bfhi(u0[0])); o.y = pk2(s2 * inv - bflo(u0[1]), s3 * inv - bfhi(u0[1]));
        o.z = pk2(s4 * inv - bflo(u0[2]), s5 * inv - bfhi(u0[2])); o.w = pk2(s6 * inv - bflo(u0[3]), s7 * inv - bfhi(u0[3]));
        const bf16x8 pfk = as_bf16x8(o);
        if (t0 == SEQ - 16 && fr >= 1) { float* pp = a.out + O_PP + (size_t)(b * 15 + fr - 1) * 512 + gi * 128 + c0;
            *(f32x4*)pp = (f32x4){bflo(u0[0]), bfhi(u0[0]), bflo(u0[1]), bfhi(u0[1])}; *(f32x4*)(pp + 4) = (f32x4){bflo(u0[2]), bfhi(u0[2]), bflo(u0[3]), bfhi(u0[3])}; }
        POOL_MMA_STEP();
    }
    constexpr bool SAMPLE_STORE = false;
    POOL_STORE(b * SEQ + t);
}
__device__ __forceinline__ void p2_pool_prompt_job(const Args& a, int job, int lane) {
    const int r = job >> 11, q = job & 2047, gi = r ? 3 - (q & 3) : (q & 3), bt = (q >> 2) + r * 512, b = bt >> 7, t0 = (bt & 127) * 16;
    if (gi == 0) pool_prompt_body<2>(a, b, t0, 0, lane); else if (gi == 1) pool_prompt_body<4>(a, b, t0, 1, lane);
    else if (gi == 2) pool_prompt_body<8>(a, b, t0, 2, lane); else pool_prompt_body<16>(a, b, t0, 3, lane);
}

template <int WIN> __device__ __forceinline__ void pool_sample_body(const Args& a, int tile, int gi, int lane_) {
    int lane = lane_; asm volatile("" : "+v"(lane));
    const int fr = lane & 15, fq = lane >> 4, bsi = tile * 16 + fr;
    const bf16* ZS = (const bf16*)(a.ws + WS_ZS); const bf16* WP = (const bf16*)(a.ws + WS_WPOOL) + gi * 16384; const int wofs = (fq * 128 + fr) * 8;
    const float inv = 1.f / (float)WIN;
    f32x4 acc[8];
#pragma unroll
    for (int dt = 0; dt < 8; ++dt) acc[dt] = (f32x4){0.f, 0.f, 0.f, 0.f};
#pragma unroll 1
    for (int ks = 0; ks < 4; ++ks) { const int c0 = ks * 32 + fq * 8;
        POOL_WLOAD();
        const u32x4 u0 = *(const u32x4*)(ZS + (size_t)bsi * NZS + 1536 + gi * 128 + c0);
        f32x4 p0[WIN], p1[WIN];
#pragma unroll
        for (int jj = 1; jj < WIN; ++jj) { const float* sp = a.state_pool + (size_t)(bsi * 15 + 15 - jj) * 512 + gi * 128 + c0; p0[jj] = *(const f32x4*)sp; p1[jj] = *(const f32x4*)(sp + 4); }
        __builtin_amdgcn_sched_barrier(0);
        float s0 = bflo(u0[0]), s1 = bfhi(u0[0]), s2 = bflo(u0[1]), s3 = bfhi(u0[1]), s4 = bflo(u0[2]), s5 = bfhi(u0[2]), s6 = bflo(u0[3]), s7 = bfhi(u0[3]);
#pragma unroll
        for (int jj = 1; jj < WIN; ++jj) { s0 += p0[jj][0]; s1 += p0[jj][1]; s2 += p0[jj][2]; s3 += p0[jj][3]; s4 += p1[jj][0]; s5 += p1[jj][1]; s6 += p1[jj][2]; s7 += p1[jj][3]; }
        u32x4 o; o.x = pk2(s0 * inv - bflo(u0[0]), s1 * inv - bfhi(u0[0])); o.y = pk2(s2 * inv - bflo(u0[1]), s3 * inv - bfhi(u0[1]));
        o.z = pk2(s4 * inv - bflo(u0[2]), s5 * inv - bfhi(u0[2])); o.w = pk2(s6 * inv - bflo(u0[3]), s7 * inv - bfhi(u0[3]));
        const bf16x8 pfk = as_bf16x8(o);
        POOL_MMA_STEP();
    }
    constexpr bool SAMPLE_STORE = true;
    POOL_STORE(bsi);
}
__device__ __forceinline__ void p2_pool_sample_job(const Args& a, int job, int lane) {
    const int gi = job & 3, tile = job >> 2;
    if (gi == 0) pool_sample_body<2>(a, tile, 0, lane); else if (gi == 1) pool_sample_body<4>(a, tile, 1, lane);
    else if (gi == 2) pool_sample_body<8>(a, tile, 2, lane); else pool_sample_body<16>(a, tile, 3, lane);
}

__device__ __forceinline__ void p2_sample_item(const Args& a, unsigned char* lds, int it2, int tid, int lane, int wave) {
    const int bs = it2 >> 2, h = it2 & 3, r = MP + bs, sh = bs * 4 + h;
    const bf16* ZS = (const bf16*)(a.ws + WS_ZS) + (size_t)bs * NZS; const float* GATES = (const float*)(a.ws + WS_GATES); bf16* MIX = (bf16*)(a.ws + WS_H);
    float* qs = (float*)lds; float* ks = qs + 128; float* vs = qs + 256; float* scal = qs + 384; float* hs = qs + 512; float* red = qs + 1024;
    if (tid < 128) { qs[tid] = bf2f(ZS[h * 128 + tid]); ks[tid] = bf2f(ZS[512 + h * 128 + tid]); vs[tid] = bf2f(ZS[2048 + h * 128 + tid]); }
    __syncthreads();
    if (wave == 0) {
        const float n0a = a.state_n[(size_t)sh * 128 + lane], n0b = a.state_n[(size_t)sh * 128 + 64 + lane];
        const float qk = wave_sum(qs[lane] * ks[lane] + qs[lane + 64] * ks[lane + 64]);
        const float qn = wave_sum(qs[lane] * n0a + qs[lane + 64] * n0b);
        const float ig = GATES[(size_t)r * 8 + h], lf = GATES[(size_t)r * 8 + 4 + h], m0 = a.state_m[sh];
        const float g = lf + m0, m = fmaxf(g, ig), w = __expf(ig - m), al = __expf(g - m);
        const float s = qk * w, den = al * qn + s, dn = fmaxf(fabsf(den), __expf(-m));
        if (lane == 0) { scal[0] = al; scal[1] = w; scal[2] = s; scal[3] = dn; a.out[O_MS + sh] = m; }
        a.out[O_NS + (size_t)sh * 128 + lane] = al * n0a + w * ks[lane]; a.out[O_NS + (size_t)sh * 128 + 64 + lane] = al * n0b + w * ks[lane + 64];
    }
    __syncthreads();
    {
        const int e4 = (tid & 31) * 4, dg = tid >> 5; const float al = scal[0], w = scal[1];
        const f32x4 v4 = *(const f32x4*)(vs + e4); f32x4 part = (f32x4){0.f, 0.f, 0.f, 0.f};
        const float* C0 = a.state_C + (size_t)sh * 16384; float* C1 = a.out + O_CS + (size_t)sh * 16384;
        f32x4 c0[8];
#pragma unroll
        for (int dd = 0; dd < 8; ++dd) c0[dd] = *(const f32x4*)(C0 + (dg * 8 + dd) * 128 + e4);
#pragma unroll
        for (int dd = 0; dd < 8; ++dd) { const int d = dg * 8 + dd; part += c0[dd] * qs[d]; *(f32x4*)(C1 + d * 128 + e4) = c0[dd] * al + v4 * (w * ks[d]); }
        *(f32x4*)(red + dg * 128 + e4) = part;
    }
    __syncthreads();
    if (tid < 128) { float qc = 0.f;
#pragma unroll
        for (int dg = 0; dg < 16; ++dg) qc += red[dg * 128 + tid];
        hs[tid] = (scal[0] * qc + scal[2] * vs[tid]) / scal[3]; }
    __syncthreads();
    if (wave == 0) {
        const float h0 = hs[lane], h1 = hs[lane + 64];
        const float rstd = rsqrtf(wave_sum(h0 * h0 + h1 * h1) * (1.f / 128.f) + EPS);
        const float o0 = bf2f(ZS[1024 + h * 128 + lane]), o1 = bf2f(ZS[1024 + h * 128 + 64 + lane]);
        bf16* MIXS = (bf16*)(a.ws + WS_MIXS);
        MIXS[cm128(bs, h * 128 + lane)] = (bf16)f2bf(h0 * rstd * a.g_head[lane] * sigmoidf_(o0));
        MIXS[cm128(bs, h * 128 + 64 + lane)] = (bf16)f2bf(h1 * rstd * a.g_head[lane + 64] * sigmoidf_(o1));
    }
    for (int idx = tid; idx < 15 * 128; idx += 512) { const int i = idx >> 7, cc = h * 128 + (idx & 127);
        a.out[O_PS + (size_t)(bs * 15 + i) * 512 + cc] = i < 14 ? a.state_pool[(size_t)(bs * 15 + i + 1) * 512 + cc] : bf2f(ZS[1536 + cc]); }
    __syncthreads();
}

#ifndef PROBE_P2SUB
#define PROBE_P2SUB 0
#endif
__device__ __forceinline__ void phase2(const Args& a, unsigned char* lds, int gw, int NGW, int tid, int lane, int wave) {
    for (int rp = 0; rp < 1 + ((PROBE_P2SUB & 1) ? 2 : 0); ++rp)
    for (int it = blockIdx.x; it < 512; it += gridDim.x) p2_sample_item(a, lds, it, tid, lane, wave);
    for (int rp = 0; rp < 1 + ((PROBE_P2SUB & 2) ? 2 : 0); ++rp)
    for (int job = gw; job < 4096; job += NGW) p2_chunk_job(a, job, lane);
    for (int rp = 0; rp < 1 + ((PROBE_P2SUB & 4) ? 2 : 0); ++rp)
    for (int job = gw; job < 4096 + 32; job += NGW) { if (job < 4096) p2_pool_prompt_job(a, job, lane); else p2_pool_sample_job(a, job - 4096, lane); }
}

__device__ __forceinline__ void phase3(const Args& a, int tid) {
    const bf16* U = (const bf16*)(a.ws + WS_U); bf16* CST = (bf16*)(a.ws + WS_CST);
    const float* CHB = (const float*)(a.ws + WS_CHB); const float* CHM = (const float*)(a.ws + WS_CHM); float* MST = (float*)(a.ws + WS_MST);
    const float* NU = (const float*)(a.ws + WS_NU); float* NST = (float*)(a.ws + WS_NST);
    for (int idx = blockIdx.x * 512 + tid; idx < 32 * 4096; idx += gridDim.x * 512) {
        const int bh = idx >> 12, rem = idx & 4095, e = (rem >> 1) & 127, d4 = (rem >> 8) * 8 + (rem & 1) * 4;
        f32x4 C = (f32x4){0.f, 0.f, 0.f, 0.f}; float m = 0.f, nacc = 0.f;
#pragma unroll 8
        for (int c = 0; c < NCH; ++c) { const int it = bh * 32 + c;
            const u32x2 uw = *(const u32x2*)(U + (size_t)it * 16384 + rem * 4); const f32x4 u = (f32x4){bflo(uw.x), bfhi(uw.x), bflo(uw.y), bfhi(uw.y)};
            u32x2 o; o.x = pk2(C[0], C[1]); o.y = pk2(C[2], C[3]); *(u32x2*)(CST + (size_t)it * 16384 + rem * 4) = o;
            float nu = 0.f;
            if (rem < 128) { NST[(size_t)it * 128 + rem] = nacc; nu = NU[(size_t)it * 128 + rem]; }
            if (rem == 0) MST[it] = m;
            const float B = CHB[it], ml = CHM[it], m2 = fmaxf(B + m, ml), al = __expf(B + m - m2), be = __expf(ml - m2);
            C = C * al + u * be; nacc = al * nacc + be * nu; m = m2; }
        float* CP = a.out + O_CP + (size_t)bh * 16384;
#pragma unroll
        for (int i = 0; i < 4; ++i) CP[(d4 + i) * 128 + e] = C[i];
        if (rem < 128) a.out[O_NP + (size_t)bh * 128 + rem] = nacc;
        if (rem == 0) a.out[O_MP + bh] = m;
    }
}

__device__ __forceinline__ void p4_job(const Args& a, int job, int lane_) {
    int lane = lane_; asm volatile("" : "+v"(lane));
    const int it = job >> 2, tt = job & 3, bh = it >> 5, c = it & 31, b = bh >> 2, h = bh & 3, r0 = b * SEQ + c * 64;
    const int fr = lane & 15, fq = lane >> 4, tl = tt * 16 + fr;
    const bf16* Z = (const bf16*)(a.ws + WS_Z); const float* GATES = (const float*)(a.ws + WS_GATES); bf16* MIX = (bf16*)(a.ws + WS_H);
    const bf16* CST = (const bf16*)(a.ws + WS_CST) + (size_t)it * 16384; const bf16* ZT = (const bf16*)(a.ws + WS_ZT);
    const float lf = GATES[(size_t)(r0 + lane) * 8 + 4 + h], ig = GATES[(size_t)(r0 + lane) * 8 + h];
    const float m0 = ((const float*)(a.ws + WS_MST))[it];
    bf16x8 qf[4], kf[4][4];
#pragma unroll
    for (int ks = 0; ks < 4; ++ks) qf[ks] = *(const bf16x8*)(Z + zc(r0 + tl, h * 128 + ks * 32 + fq * 8));
#pragma unroll
    for (int st = 0; st < 4; ++st)
#pragma unroll
        for (int ks = 0; ks < 4; ++ks) kf[st][ks] = *(const bf16x8*)(Z + zc(r0 + st * 16 + fr, 512 + h * 128 + ks * 32 + fq * 8));
    f32x4 n0v[4][2];
    { const float* n0 = (const float*)(a.ws + WS_NST) + (size_t)it * 128;
#pragma unroll
        for (int ks = 0; ks < 4; ++ks) { n0v[ks][0] = *(const f32x4*)(n0 + ks * 32 + fq * 8); n0v[ks][1] = *(const f32x4*)(n0 + ks * 32 + fq * 8 + 4); } }
    __builtin_amdgcn_sched_barrier(0);
    const float bs = scan_add(lf, lane); const float cs = ig - bs; const float pm = scan_max(cs, lane); const float mt = bs + fmaxf(m0, pm); const float at = __expf(bs + m0 - mt);
    const float bm_t = __shfl(bs - mt, tl), a_t = __shfl(at, tl), em_t = __expf(-__shfl(mt, tl));
    float sv[4][4]; float ssum = 0.f;
#pragma unroll
    for (int st = 0; st < 4; ++st) { f32x4 acc = (f32x4){0.f, 0.f, 0.f, 0.f};
#pragma unroll
        for (int ks = 0; ks < 4; ++ks) acc = mfma16(kf[st][ks], qf[ks], acc);
#pragma unroll
        for (int j = 0; j < 4; ++j) { const int s = st * 16 + fq * 4 + j; const float cj = __shfl(cs, s);
            const float w = (s <= tl) ? __expf(bm_t + cj) : 0.f; sv[st][j] = acc[j] * w; ssum += sv[st][j]; } }
    ssum += __shfl_xor(ssum, 16); ssum += __shfl_xor(ssum, 32);
    bf16x8 sf[2];
#pragma unroll
    for (int kp = 0; kp < 2; ++kp) { u32x4 w; w.x = pk2(sv[2 * kp][0], sv[2 * kp][1]); w.y = pk2(sv[2 * kp][2], sv[2 * kp][3]); w.z = pk2(sv[2 * kp + 1][0], sv[2 * kp + 1][1]); w.w = pk2(sv[2 * kp + 1][2], sv[2 * kp + 1][3]); sf[kp] = as_bf16x8(w); }
    f32x4 accn = (f32x4){0.f, 0.f, 0.f, 0.f};
#pragma unroll
    for (int ks = 0; ks < 4; ++ks) { const f32x4 x0 = n0v[ks][0], x1 = n0v[ks][1];
        u32x4 w; w.x = pk2(x0[0], x0[1]); w.y = pk2(x0[2], x0[3]); w.z = pk2(x1[0], x1[1]); w.w = pk2(x1[2], x1[3]); accn = mfma16(as_bf16x8(w), qf[ks], accn); }
    const float inv = 1.f / fmaxf(fabsf(a_t * accn[0] + ssum), em_t);
    f32x4 hT[8]; float ss = 0.f;
    bf16x8 cb[4][4]; u32x2 vlo[4][2], vhi[4][2];
#define P4_LOAD(buf, et) do { _Pragma("unroll") for (int ks = 0; ks < 4; ++ks) cb[buf][ks] = *(const bf16x8*)(CST + ((ks * 4 + fq) * 128 + (et) * 16 + fr) * 8); \
        _Pragma("unroll") for (int kp = 0; kp < 2; ++kp) { const bf16* vp = ZT + ztc(512 + h * 128 + (et) * 16 + fr, r0 + kp * 32 + fq * 4); vlo[buf][kp] = *(const u32x2*)vp; vhi[buf][kp] = *(const u32x2*)(vp + (size_t)2 * ZTR * 8); } } while (0)
#pragma unroll
    for (int eg = 0; eg < 2; ++eg) {
#pragma unroll
        for (int i = 0; i < 4; ++i) P4_LOAD(i, eg * 4 + i);
        __builtin_amdgcn_sched_barrier(0);
#pragma unroll
        for (int i = 0; i < 4; ++i) { const int et = eg * 4 + i;
            f32x4 acc1 = (f32x4){0.f, 0.f, 0.f, 0.f}, acc2 = (f32x4){0.f, 0.f, 0.f, 0.f};
#pragma unroll
            for (int ks = 0; ks < 4; ++ks) acc1 = mfma16(cb[i][ks], qf[ks], acc1);
#pragma unroll
            for (int kp = 0; kp < 2; ++kp) { u32x4 w; w.x = vlo[i][kp].x; w.y = vlo[i][kp].y; w.z = vhi[i][kp].x; w.w = vhi[i][kp].y; acc2 = mfma16(as_bf16x8(w), sf[kp], acc2); }
#pragma unroll
            for (int j = 0; j < 4; ++j) { const float hv = (a_t * acc1[j] + acc2[j]) * inv; hT[et][j] = hv; ss += hv * hv; } }
        __builtin_amdgcn_sched_barrier(0);
    }
#undef P4_LOAD
    ss += __shfl_xor(ss, 16); ss += __shfl_xor(ss, 32);
    const float rstd = rsqrtf(ss * (1.f / 128.f) + EPS);
    bf16* mrow = MIX + (size_t)(r0 + tl) * D + h * 128;
    u32x2 ow[8];
#pragma unroll
    for (int et = 0; et < 8; ++et) ow[et] = *(const u32x2*)(Z + zc(r0 + tl, 1024 + h * 128 + et * 16 + fq * 4));
    __builtin_amdgcn_sched_barrier(0);
#pragma unroll
    for (int et = 0; et < 8; ++et) { const f32x4 gh = *(const f32x4*)(a.g_head + et * 16 + fq * 4);
        u32x2 o; o.x = pk2(hT[et][0] * rstd * gh[0] * sigmoidf_(bflo(ow[et].x)), hT[et][1] * rstd * gh[1] * sigmoidf_(bfhi(ow[et].x)));
        o.y = pk2(hT[et][2] * rstd * gh[2] * sigmoidf_(bflo(ow[et].y)), hT[et][3] * rstd * gh[3] * sigmoidf_(bfhi(ow[et].y)));
        *(u32x2*)(mrow + et * 16 + fq * 4) = o; }
}

__device__ __forceinline__ void phase6(const Args& a, int gw, int NGW, int lane) {
    const float* MOD = (const float*)(a.ws + WS_MOD); const float* T1 = (const float*)(a.ws + WS_T1); bf16* HN = (bf16*)(a.ws + WS_H);
    for (int row = gw; row < MT; row += NGW) {
        const float* xr = row < MP ? a.x_prompt + (size_t)row * D : a.x_sample + (size_t)(row - MP) * D;
        const float* md = MOD + (size_t)mod_row(row) * MODC; const float* tr = T1 + (size_t)row * D; float* orow = a.out + (size_t)row * D;
        f32x4 t[4], x1[4]; float ss = 0.f;
#pragma unroll
        for (int j = 0; j < 4; ++j) { t[j] = *(const f32x4*)(tr + j * 256 + lane * 4); ss += (t[j][0] * t[j][0] + t[j][1] * t[j][1]) + (t[j][2] * t[j][2] + t[j][3] * t[j][3]); }
        const float rstd = rsqrtf(wave_sum(ss) * (1.f / D) + EPS); float ss2 = 0.f;
#pragma unroll
        for (int j = 0; j < 4; ++j) { const int col = j * 256 + lane * 4;
            const f32x4 xv = *(const f32x4*)(xr + col), gp = *(const f32x4*)(a.g_post1 + col), ga = *(const f32x4*)(md + 2 * D + col);
            x1[j] = xv + ga * (t[j] * rstd * gp); *(f32x4*)(orow + col) = x1[j];
            ss2 += (x1[j][0] * x1[j][0] + x1[j][1] * x1[j][1]) + (x1[j][2] * x1[j][2] + x1[j][3] * x1[j][3]); }
        const float rstd2 = rsqrtf(wave_sum(ss2) * (1.f / D) + EPS);
#pragma unroll
        for (int j = 0; j < 4; ++j) { const int col = j * 256 + lane * 4;
            const f32x4 gp = *(const f32x4*)(a.g_pre2 + col), sh = *(const f32x4*)(md + 3 * D + col), sc = *(const f32x4*)(md + 4 * D + col);
            const f32x4 h = x1[j] * rstd2 * gp * (sc + 1.f) + sh;
            u32x2 o; o.x = pk2(h[0], h[1]); o.y = pk2(h[2], h[3]); *(u32x2*)(HN + (size_t)row * D + col) = o;
            if (row >= MP) *(u32x2*)((bf16*)(a.ws + WS_HNS) + cm128(row - MP, col)) = o; }
    }
}

__device__ __forceinline__ void phase9(const Args& a, int gw, int NGW, int lane) {
    const float* MOD = (const float*)(a.ws + WS_MOD); const bf16* T2 = (const bf16*)(a.ws + WS_T2);
    for (int row = gw; row < MT; row += NGW) {
        const float* md = MOD + (size_t)mod_row(row) * MODC; const bf16* tr = T2 + (size_t)row * D; float* orow = a.out + (size_t)row * D;
        f32x4 t[4]; float ss = 0.f;
#pragma unroll
        for (int j = 0; j < 4; ++j) { const u32x2 w = *(const u32x2*)(tr + j * 256 + lane * 4); t[j] = (f32x4){bflo(w.x), bfhi(w.x), bflo(w.y), bfhi(w.y)};
            ss += (t[j][0] * t[j][0] + t[j][1] * t[j][1]) + (t[j][2] * t[j][2] + t[j][3] * t[j][3]); }
        const float rstd = rsqrtf(wave_sum(ss) * (1.f / D) + EPS);
#pragma unroll
        for (int j = 0; j < 4; ++j) { const int col = j * 256 + lane * 4;
            const f32x4 xv = *(const f32x4*)(orow + col), gp = *(const f32x4*)(a.g_post2 + col), ga = *(const f32x4*)(md + 5 * D + col);
            *(f32x4*)(orow + col) = xv + ga * (t[j] * rstd * gp); }
    }
}

#define LAS __attribute__((address_space(3)))
#define XB_TMO      128
#define XB_XCNT(j)  (256  + 64 * (j))
#define XB_XSUB(j)  (1280 + 64 * (j))
#define XB_XGEN(j)  (2304 + 64 * (j))
#define XB_TOP      3328
#define XB_TOPGEN   3392
#define XCD_BAR_WORDS 3456
#define XB_SPIN_CAP (1u << 18)

__device__ __forceinline__ unsigned xb_ld(unsigned* p)              { return __hip_atomic_load(p, __ATOMIC_RELAXED, __HIP_MEMORY_SCOPE_AGENT); }
__device__ __forceinline__ unsigned xb_add(unsigned* p, unsigned v) { return __hip_atomic_fetch_add(p, v, __ATOMIC_RELAXED, __HIP_MEMORY_SCOPE_AGENT); }
__device__ __forceinline__ unsigned xb_xcc_id() { return (unsigned)__builtin_amdgcn_s_getreg((3 << 11) | 20) & 0xFu; }
#define XB_SPIN(cond, bar) do { unsigned _sp = 0; while (cond) { __builtin_amdgcn_s_sleep(1); \
    if ((++_sp & 255u) == 0u) { if (xb_ld(&(bar)[XB_TMO])) break; if (_sp > XB_SPIN_CAP) { atomicAdd(&(bar)[XB_TMO], 1u); break; } } } } while (0)

struct XcdBarrier {
    unsigned* bar; unsigned x;
    volatile LAS unsigned* st;
};

__device__ __forceinline__ XcdBarrier xcd_barrier_post(unsigned* bar, volatile LAS unsigned* st) {
    XcdBarrier b; b.bar = bar; b.x = xb_xcc_id(); b.st = st;
    if (threadIdx.x == 0) (void)xb_add(&bar[XB_XCNT(b.x)], 1u);
    return b;
}
__device__ __forceinline__ void xcd_barrier_complete(unsigned* bar, unsigned x, unsigned& nloc, unsigned& nx) {
    const unsigned G = gridDim.x * gridDim.y * gridDim.z;
    unsigned sum, cnt, mine, sp = 0u;
    for (;;) {
        sum = 0u; cnt = 0u; mine = 0u;
#pragma unroll
        for (unsigned j = 0; j < 16; ++j) { const unsigned c = xb_ld(&bar[XB_XCNT(j)]); sum += c; cnt += (c > 0u) ? 1u : 0u; mine = (j == x) ? c : mine; }
        if (sum == G) break;
        __builtin_amdgcn_s_sleep(1);
        if ((++sp & 255u) == 0u) { if (xb_ld(&bar[XB_TMO])) break; if (sp > XB_SPIN_CAP) { atomicAdd(&bar[XB_TMO], 1u); break; } }
    }
    nloc = mine > 0u ? mine : 1u; nx = cnt > 0u ? cnt : 1u;
}

__device__ __forceinline__ void xcd_barrier(const XcdBarrier& b) {
    asm volatile("s_waitcnt vmcnt(0)" ::: "memory");
    __syncthreads();
    if (threadIdx.x == 0) {
        unsigned* bar = b.bar;
        __builtin_amdgcn_s_waitcnt(0);
        unsigned nloc = b.st[0], nx = b.st[1];
        if (nloc == 0u) { xcd_barrier_complete(bar, b.x, nloc, nx); b.st[0] = nloc; b.st[1] = nx; }
        const unsigned old = xb_add(&bar[XB_XSUB(b.x)], 1u);
        const unsigned gen = old / nloc;
        if (old + 1u == (gen + 1u) * nloc) {
            __builtin_amdgcn_fence(__ATOMIC_RELEASE, "agent");
            asm volatile("s_waitcnt vmcnt(0)" ::: "memory");
            const unsigned og = xb_add(&bar[XB_TOP], 1u);
            const unsigned tg = og / nx;
            if (og + 1u == (tg + 1u) * nx) xb_add(&bar[XB_TOPGEN], 1u);
            else XB_SPIN(xb_ld(&bar[XB_TOPGEN]) == tg, bar);
            __builtin_amdgcn_fence(__ATOMIC_ACQUIRE, "agent");
            xb_add(&bar[XB_XGEN(b.x)], 1u);
            asm volatile("s_waitcnt vmcnt(0)" ::: "memory");
        } else {
            XB_SPIN(xb_ld(&bar[XB_XGEN(b.x)]) == gen, bar);
            __builtin_amdgcn_fence(__ATOMIC_ACQUIRE, "agent");
            asm volatile("s_waitcnt vmcnt(0)" ::: "memory");
        }
    }
    __syncthreads();
}

__global__ void __launch_bounds__(NWAVES * 64, 2) mk_fwd(Args a) {
    extern __shared__ __attribute__((aligned(16))) unsigned char lds[];
    cg::grid_group grid = cg::this_grid();
    const int tid = threadIdx.x, lane = tid & 63, wave = __builtin_amdgcn_readfirstlane(tid >> 6);
    const int G = gridDim.x, gw = blockIdx.x * NWAVES + wave, NGW = G * NWAVES;
    const int gwr = (G - 1 - (int)blockIdx.x) * NWAVES + wave;
    PG8_LAS unsigned char* ldsl = (PG8_LAS unsigned char*)lds;
    unsigned char* ws = a.ws;
    const int lo = a.ph_lo, hi = a.ph_hi;
    if (lo > 1000) grid.sync();
    if (tid < 64) ((unsigned*)(lds + 131072))[tid] = 0u;
    __syncthreads();
    XcdBarrier bar = xcd_barrier_post((unsigned*)ws + CW_BAR, (volatile LAS unsigned*)(lds + 131072) + 8);
#define IN(k) (lo <= (k) && (k) < hi)
#define GSYNC() xcd_barrier(bar)
#define SEAM(k) do { if (IN(k) && IN((k) + 1)) GSYNC(); } while (0)
#ifndef PROBE_MASK
#define PROBE_MASK 0
#endif
#ifndef PROBE_SYNCS
#define PROBE_SYNCS 0
#endif
#define REPS(k) (((PROBE_MASK >> (k)) & 1) ? 2 : 0)
#define PRE(k) for (int rep_ = 0; rep_ < REPS(k); ++rep_)
    for (int i_ = 0; i_ < PROBE_SYNCS; ++i_) GSYNC();

    PRE(0) {
        if (IN(0)) phase0(a, lds, gw, NGW, lane, wave);
        GSYNC(); }
    if (IN(0)) phase0(a, lds, gw, NGW, lane, wave);
    SEAM(0);
    PRE(1) {
        if (IN(1)) small_gemm<0>((const bf16*)(ws + WS_SILU), NMODP, (const bf16*)(ws + WS_WADA), MODC, MODC, D, NMODP / 16, gw, NGW, lane, ws + WS_MOD, a.b_ada);
        GSYNC(); }
    if (IN(1)) small_gemm<0>((const bf16*)(ws + WS_SILU), NMODP, (const bf16*)(ws + WS_WADA), MODC, MODC, D, NMODP / 16, gw, NGW, lane, ws + WS_MOD, a.b_ada);
    SEAM(1);
    PRE(2) {
        if (IN(2)) phase1a(a, lds, gw, NGW, lane, tid);
        GSYNC(); }
    if (IN(2)) phase1a(a, lds, gw, NGW, lane, tid);
    SEAM(2);
    PRE(3) {
        if (IN(3)) {
            { pg8::Gemm g{(const bf16*)(ws + WS_H), (const bf16*)(ws + WS_WIN), MP, NZ, D}; pg8::StaticOrder S; S.init(MP, NZ, G, (int)blockIdx.x);
              pg8::EpiB16CM E{(bf16*)(ws + WS_Z), ZR};
              pg8::gemm_phase<pg8::EpiB16CM, pg8::StaticOrder, true, true>(ldsl, g, S, E); }
            { pg8::Gemm g{(const bf16*)(ws + WS_WIN) + (size_t)2048 * D, (const bf16*)(ws + WS_H), 1024, MP, D}; pg8::StaticOrder S; S.init(1024, MP, G, (int)blockIdx.x);
              pg8::EpiB16CM E{(bf16*)(ws + WS_ZT), ZTR};
              pg8::gemm_phase<pg8::EpiB16CM, pg8::StaticOrder, false, true>(ldsl, g, S, E); }
            small_gemm<1>((const bf16*)(ws + WS_HNS), 128, (const bf16*)(ws + WS_WINC), 3072, NZS, D, MS / 16, gw, NGW, lane, ws + WS_ZS, nullptr);
        }
        GSYNC(); }
    if (IN(3)) {
        { pg8::Gemm g{(const bf16*)(ws + WS_H), (const bf16*)(ws + WS_WIN), MP, NZ, D}; pg8::StaticOrder S; S.init(MP, NZ, G, (int)blockIdx.x);
          pg8::EpiB16CM E{(bf16*)(ws + WS_Z), ZR};
          pg8::gemm_phase<pg8::EpiB16CM, pg8::StaticOrder, true, true>(ldsl, g, S, E); }
        { pg8::Gemm g{(const bf16*)(ws + WS_WIN) + (size_t)2048 * D, (const bf16*)(ws + WS_H), 1024, MP, D}; pg8::StaticOrder S; S.init(1024, MP, G, (int)blockIdx.x);
          pg8::EpiB16CM E{(bf16*)(ws + WS_ZT), ZTR};
          pg8::gemm_phase<pg8::EpiB16CM, pg8::StaticOrder, false, true>(ldsl, g, S, E); }
        small_gemm<1>((const bf16*)(ws + WS_HNS), 128, (const bf16*)(ws + WS_WINC), 3072, NZS, D, MS / 16, gw, NGW, lane, ws + WS_ZS, nullptr);
    }
    SEAM(3);
    PRE(4) {
        if (IN(4)) phase2(a, lds, gw, NGW, tid, lane, wave);
        GSYNC(); }
    if (IN(4)) phase2(a, lds, gw, NGW, tid, lane, wave);
    SEAM(4);
    PRE(5) {
        if (IN(5)) phase3(a, tid);
        GSYNC(); }
    if (IN(5)) phase3(a, tid);
    SEAM(5);
    PRE(6) {
        if (IN(6)) { for (int job = gw; job < 4096; job += NGW) p4_job(a, job, lane); }
        GSYNC(); }
    if (IN(6)) { for (int job = gw; job < 4096; job += NGW) p4_job(a, job, lane); }
    SEAM(6);
    PRE(7) {
        if (IN(7)) {
            pg8::Gemm g{(const bf16*)(ws + WS_H), (const bf16*)(ws + WS_WOUT), MP, D, D}; pg8::StaticOrder S; S.init(MP, D, G, (int)blockIdx.x);
            pg8::EpiF32 E{(float*)(ws + WS_T1), D};
            pg8::gemm_phase<pg8::EpiF32, pg8::StaticOrder, false, true>(ldsl, g, S, E);
            small_gemm<2>((const bf16*)(ws + WS_MIXS), 128, (const bf16*)(ws + WS_WOUTC), D, D, D, MS / 16, gw, NGW, lane, (float*)(ws + WS_T1) + (size_t)MP * D, nullptr);
        }
        GSYNC(); }
    if (IN(7)) {
        pg8::Gemm g{(const bf16*)(ws + WS_H), (const bf16*)(ws + WS_WOUT), MP, D, D}; pg8::StaticOrder S; S.init(MP, D, G, (int)blockIdx.x);
        pg8::EpiF32 E{(float*)(ws + WS_T1), D};
        pg8::gemm_phase<pg8::EpiF32, pg8::StaticOrder, false, true>(ldsl, g, S, E);
        small_gemm<2>((const bf16*)(ws + WS_MIXS), 128, (const bf16*)(ws + WS_WOUTC), D, D, D, MS / 16, gw, NGW, lane, (float*)(ws + WS_T1) + (size_t)MP * D, nullptr);
    }
    SEAM(7);
    PRE(8) {
        if (IN(8)) phase6(a, gw, NGW, lane);
        GSYNC(); }
    if (IN(8)) phase6(a, gw, NGW, lane);
    SEAM(8);
    PRE(9) {
        if (IN(9)) {
            pg8::Gemm g{(const bf16*)(ws + WS_H), (const bf16*)(ws + WS_WUP), MP, FF, D}; pg8::StaticOrder S; S.init(MP, FF, G, (int)blockIdx.x);
            pg8::EpiB16<1> E{(bf16*)(ws + WS_F), FF};
            pg8::gemm_phase<pg8::EpiB16<1>, pg8::StaticOrder, true, true>(ldsl, g, S, E);
            small_gemm<3>((const bf16*)(ws + WS_HNS), 128, (const bf16*)(ws + WS_WUPC), FF, FF, D, MS / 16, gw, NGW, lane, ws + WS_FS, nullptr);
        }
        GSYNC(); }
    if (IN(9)) {
        pg8::Gemm g{(const bf16*)(ws + WS_H), (const bf16*)(ws + WS_WUP), MP, FF, D}; pg8::StaticOrder S; S.init(MP, FF, G, (int)blockIdx.x);
        pg8::EpiB16<1> E{(bf16*)(ws + WS_F), FF};
        pg8::gemm_phase<pg8::EpiB16<1>, pg8::StaticOrder, true, true>(ldsl, g, S, E);
        small_gemm<3>((const bf16*)(ws + WS_HNS), 128, (const bf16*)(ws + WS_WUPC), FF, FF, D, MS / 16, gw, NGW, lane, ws + WS_FS, nullptr);
    }
    SEAM(9);
    PRE(10) {
        if (IN(10)) {
            pg8::Gemm g{(const bf16*)(ws + WS_F), (const bf16*)(ws + WS_WDN), MP, D, FF}; pg8::StaticOrder S; S.init(MP, D, G, (int)blockIdx.x);
            pg8::EpiB16<0> E{(bf16*)(ws + WS_T2), D};
            pg8::gemm_phase<pg8::EpiB16<0>, pg8::StaticOrder, false, true>(ldsl, g, S, E);
            small_gemm_down((const bf16*)(ws + WS_FS), (const bf16*)(ws + WS_WDNC), lds, lane, wave, (bf16*)(ws + WS_T2) + (size_t)MP * D);
        }
        GSYNC(); }
    if (IN(10)) {
        pg8::Gemm g{(const bf16*)(ws + WS_F), (const bf16*)(ws + WS_WDN), MP, D, FF}; pg8::StaticOrder S; S.init(MP, D, G, (int)blockIdx.x);
        pg8::EpiB16<0> E{(bf16*)(ws + WS_T2), D};
        pg8::gemm_phase<pg8::EpiB16<0>, pg8::StaticOrder, false, true>(ldsl, g, S, E);
        small_gemm_down((const bf16*)(ws + WS_FS), (const bf16*)(ws + WS_WDNC), lds, lane, wave, (bf16*)(ws + WS_T2) + (size_t)MP * D);
    }
    SEAM(10);
    if (IN(11)) phase9(a, gw, NGW, lane);
#undef IN
#undef SEAM
}

#ifndef MK_SPLIT
#define MK_SPLIT 0
#endif
extern "C" void kernel_launch(void* const* d_in, const int* in_sizes, int n_in, void* d_out, int out_size, void* d_ws, size_t ws_size, hipStream_t stream) {
    static int grid = 0;
    if (grid == 0) {
        int dev = 0, cus = 0, per_cu = 0;
        if (hipGetDevice(&dev) != hipSuccess || hipDeviceGetAttribute(&cus, hipDeviceAttributeMultiprocessorCount, dev) != hipSuccess) { fprintf(stderr, "kernel_launch: device query failed\n"); grid = -1; return; }
        if (hipFuncSetAttribute((const void*)mk_fwd, hipFuncAttributeMaxDynamicSharedMemorySize, LDS_BYTES) != hipSuccess) { fprintf(stderr, "kernel_launch: hipFuncSetAttribute failed\n"); grid = -1; return; }
        if (hipOccupancyMaxActiveBlocksPerMultiprocessor(&per_cu, (const void*)mk_fwd, NWAVES * 64, LDS_BYTES) != hipSuccess || per_cu < 1) { fprintf(stderr, "kernel_launch: occupancy query says %d\n", per_cu); per_cu = 1; }
        (void)hipGetLastError();
        grid = cus;
        if (n_in != 23 || out_size != (int)O_END || ws_size < 256 * MiB) fprintf(stderr, "kernel_launch: unexpected sizes n_in %d out %d ws %zu\n", n_in, out_size, ws_size);
    }
    if (grid < 0) return;
    Args a{};
    const float** pp = (const float**)&a;
    for (int i = 0; i < 23; ++i) pp[i] = (const float*)d_in[i];
    a.out = (float*)d_out; a.ws = (unsigned char*)d_ws;
    if (hipMemsetAsync(d_ws, 0, CTL_ZERO_BYTES, stream) != hipSuccess) { fprintf(stderr, "kernel_launch: memset failed\n"); return; }
#if MK_SPLIT
    for (int p = 0; p < 12; ++p) { a.ph_lo = p; a.ph_hi = p + 1; hipLaunchKernelGGL(mk_fwd, dim3(grid), dim3(NWAVES * 64), LDS_BYTES, stream, a); }
#else
    a.ph_lo = 0; a.ph_hi = 12;
    void* args[] = {&a};
    hipError_t e = hipLaunchCooperativeKernel((const void*)mk_fwd, dim3(grid), dim3(NWAVES * 64), args, LDS_BYTES, stream);
    if (e != hipSuccess) fprintf(stderr, "cooperative launch failed: %s (grid %d)\n", hipGetErrorString(e), grid);
#endif
}
```
